# Optimizing an MI355X kernel written in HIP

```python
import math
import jax, jax.numpy as jnp
from jax import lax
import numpy as np

D_MODEL = 1024
BATCH = 8
SEQ = 4096
DEPTH = 1

N_HEADS = 8
N_KV_HEADS = 2
HEAD_DIM = 64
GQA_GROUP = N_HEADS // N_KV_HEADS
ATTN_WIDTH = N_HEADS * HEAD_DIM
KV_WIDTH = N_KV_HEADS * HEAD_DIM
ROPE_DIM = HEAD_DIM // 4
ROPE_THETA = 500000.0
WINDOW = 128
BLOCK = 128
SSM_GROUP_CH = 16
SSM_WIDTH = D_MODEL // 2
SSM_GROUPS = SSM_WIDTH // SSM_GROUP_CH
SSM_STATE = 64
D_FF = -(-8 * D_MODEL // (3 * 256)) * 256
IN_COLS = ATTN_WIDTH + 2 * KV_WIDTH + SSM_WIDTH + 2 * D_MODEL
SPLITS = [ATTN_WIDTH, ATTN_WIDTH + KV_WIDTH, ATTN_WIDTH + 2 * KV_WIDTH,
          ATTN_WIDTH + 2 * KV_WIDTH + SSM_WIDTH,
          ATTN_WIDTH + 2 * KV_WIDTH + SSM_WIDTH + D_MODEL]
RMS_EPS = 1e-6
NEG_INF = -1e30

kernel_name = "hybrid_gated_swa_s5_encoder"


def rmsnorm(x, g):
    xf = x.astype(jnp.float32)
    xf = xf * lax.rsqrt(jnp.mean(xf * xf, axis=-1, keepdims=True) + RMS_EPS)
    return (xf * g.astype(jnp.float32)).astype(x.dtype)


def rope_tables(seq_len):
    pos = jnp.arange(seq_len, dtype=jnp.float32)
    inv_freq = ROPE_THETA ** (-jnp.arange(0, ROPE_DIM, 2, dtype=jnp.float32) / ROPE_DIM)
    ang = pos[:, None] * inv_freq[None, :]
    return jnp.cos(ang)[:, None, :], jnp.sin(ang)[:, None, :]


def partial_rope(t, cos, sin):
    t = t.astype(jnp.float32)
    r, rest = t[..., :ROPE_DIM], t[..., ROPE_DIM:]
    r1, r2 = r[..., :ROPE_DIM // 2], r[..., ROPE_DIM // 2:]
    rot = jnp.concatenate([r1 * cos - r2 * sin, r2 * cos + r1 * sin], axis=-1)
    return jnp.concatenate([rot, rest], axis=-1)


def windowed_gqa(q, k, v, sink):
    b, L = q.shape[0], q.shape[1]
    nb = L // BLOCK
    qb = q.reshape(b, nb, BLOCK, N_KV_HEADS, GQA_GROUP, HEAD_DIM)
    pad = ((0, 0), (1, 1), (0, 0), (0, 0), (0, 0))
    kp = jnp.pad(k.reshape(b, nb, BLOCK, N_KV_HEADS, HEAD_DIM), pad)
    vp = jnp.pad(v.astype(jnp.float32).reshape(b, nb, BLOCK, N_KV_HEADS, HEAD_DIM), pad)
    kw = jnp.concatenate([kp[:, :-2], kp[:, 1:-1], kp[:, 2:]], axis=2)
    vw = jnp.concatenate([vp[:, :-2], vp[:, 1:-1], vp[:, 2:]], axis=2)
    scores = jnp.einsum('bnqkgd,bnskd->bnkgqs', qb, kw) * (HEAD_DIM ** -0.5)
    blk = jnp.arange(nb)[:, None, None]
    qpos = blk * BLOCK + jnp.arange(BLOCK)[None, :, None]
    kpos = (blk - 1) * BLOCK + jnp.arange(3 * BLOCK)[None, None, :]
    valid = (jnp.abs(qpos - kpos) <= WINDOW) & (kpos >= 0) & (kpos < L)
    scores = jnp.where(valid[None, :, None, None], scores, NEG_INF)
    s = sink.astype(jnp.float32).reshape(N_KV_HEADS, GQA_GROUP)[None, None, :, :, None, None]
    m = jnp.maximum(jnp.max(scores, axis=-1, keepdims=True), s)
    p = jnp.exp(scores - m)
    p = p / (jnp.sum(p, axis=-1, keepdims=True) + jnp.exp(s - m))
    out = jnp.einsum('bnkgqs,bnskd->bnqkgd', p, vw)
    return out.reshape(b, L, ATTN_WIDTH)


def s5_scan(u, lam_re, lam_im, log_dt, b_re, b_im):
    L = u.shape[1]
    lam = lax.complex(lam_re.astype(jnp.float32), lam_im.astype(jnp.float32))
    dt = jnp.exp(log_dt.astype(jnp.float32))[:, None]
    lam_bar = jnp.exp(lam * dt)
    b_bar = ((lam_bar - 1.0) / lam)[..., None] * lax.complex(b_re.astype(jnp.float32),
                                                             b_im.astype(jnp.float32))
    bu = jnp.einsum('blgh,gph->blgp', u.astype(jnp.complex64), b_bar)
    a = jnp.broadcast_to(lam_bar, (1, L) + lam_bar.shape)

    def combine(c1, c2):
        a1, x1 = c1
        a2, x2 = c2
        return a1 * a2, a2 * x1 + x2

    _, h = lax.associative_scan(combine, (a, bu), axis=1)
    return h


def bidirectional_s5(u, lam_re, lam_im, log_dt, b_re, b_im, c_re, c_im, d, w_glu):
    b, L = u.shape[0], u.shape[1]
    ug = u.astype(jnp.float32).reshape(b, L, SSM_GROUPS, SSM_GROUP_CH)
    h_f = s5_scan(ug, lam_re[0], lam_im[0], log_dt[0], b_re[0], b_im[0])
    h_b = s5_scan(ug[:, ::-1], lam_re[1], lam_im[1], log_dt[1], b_re[1], b_im[1])[:, ::-1]
    c = lax.complex(c_re.astype(jnp.float32), c_im.astype(jnp.float32))
    y = jnp.einsum('blgp,ghp->blgh', h_f + h_b, c).real + d.astype(jnp.float32) * ug
    y = jax.nn.gelu(y.reshape(b, L, SSM_WIDTH)).astype(u.dtype)
    return y * jax.nn.sigmoid(y @ w_glu)


def setup_inputs(seed: int = 0) -> dict:
    key = jax.random.key(seed)
    ks = jax.random.split(key, 24)
    nrm = lambda k, shape, scale: jax.random.normal(k, shape, jnp.float32) * scale
    Ls, G, P, H = DEPTH, SSM_GROUPS, SSM_STATE, SSM_GROUP_CH
    lam_im_init = jnp.pi * jnp.arange(P, dtype=jnp.float32)
    return {
        "x": jax.random.normal(ks[0], (BATCH, SEQ, D_MODEL), jnp.float32),
        "norm1_g": 1.0 + nrm(ks[1], (Ls, D_MODEL), 0.02),
        "w_in": nrm(ks[2], (Ls, D_MODEL, IN_COLS), D_MODEL ** -0.5),
        "attn_sink": nrm(ks[3], (Ls, N_HEADS), 0.5),
        "ssm_lambda_re": -0.5 + nrm(ks[4], (Ls, 2, G, P), 0.01),
        "ssm_lambda_im": lam_im_init + nrm(ks[5], (Ls, 2, G, P), 0.01),
        "ssm_log_dt": jax.random.uniform(ks[6], (Ls, 2, G), jnp.float32,
                                         math.log(1e-3), math.log(1e-1)),
        "ssm_b_re": nrm(ks[7], (Ls, 2, G, P, H), (2.0 * H) ** -0.5),
        "ssm_b_im": nrm(ks[8], (Ls, 2, G, P, H), (2.0 * H) ** -0.5),
        "ssm_c_re": nrm(ks[9], (Ls, G, H, P), (2.0 * P) ** -0.5),
        "ssm_c_im": nrm(ks[10], (Ls, G, H, P), (2.0 * P) ** -0.5),
        "ssm_d": nrm(ks[11], (Ls, G, H), 1.0),
        "w_glu": nrm(ks[12], (Ls, SSM_WIDTH, SSM_WIDTH), SSM_WIDTH ** -0.5),
        "w_attn_branch": nrm(ks[13], (Ls, ATTN_WIDTH, D_MODEL), ATTN_WIDTH ** -0.5),
        "w_ssm_branch": nrm(ks[14], (Ls, SSM_WIDTH, D_MODEL), SSM_WIDTH ** -0.5),
        "w_out": nrm(ks[15], (Ls, D_MODEL, D_MODEL), D_MODEL ** -0.5),
        "norm2_g": 1.0 + nrm(ks[16], (Ls, D_MODEL), 0.02),
        "w_ffn_gate": nrm(ks[17], (Ls, D_MODEL, D_FF), D_MODEL ** -0.5),
        "w_ffn_up": nrm(ks[18], (Ls, D_MODEL, D_FF), D_MODEL ** -0.5),
        "w_ffn_down": nrm(ks[19], (Ls, D_FF, D_MODEL), D_FF ** -0.5),
        "norm_f_g": 1.0 + nrm(ks[20], (D_MODEL,), 0.02),
    }


def reference(x, norm1_g, w_in, attn_sink, ssm_lambda_re, ssm_lambda_im, ssm_log_dt,
              ssm_b_re, ssm_b_im, ssm_c_re, ssm_c_im, ssm_d, w_glu, w_attn_branch,
              w_ssm_branch, w_out, norm2_g, w_ffn_gate, w_ffn_up, w_ffn_down, norm_f_g):
    b, L, _ = x.shape
    cos, sin = rope_tables(L)
    for layer in range(DEPTH):
        h = rmsnorm(x, norm1_g[layer])
        proj = h @ w_in[layer]
        q, k, v, u, g_attn, g_ssm = jnp.split(proj, SPLITS, axis=-1)
        q = partial_rope(q.reshape(b, L, N_HEADS, HEAD_DIM), cos, sin)
        k = partial_rope(k.reshape(b, L, N_KV_HEADS, HEAD_DIM), cos, sin)
        v = v.reshape(b, L, N_KV_HEADS, HEAD_DIM)
        attn = windowed_gqa(q, k, v, attn_sink[layer]).astype(x.dtype)
        ssm = bidirectional_s5(u, ssm_lambda_re[layer], ssm_lambda_im[layer], ssm_log_dt[layer],
                               ssm_b_re[layer], ssm_b_im[layer], ssm_c_re[layer],
                               ssm_c_im[layer], ssm_d[layer], w_glu[layer])
        merged = (jax.nn.sigmoid(g_attn) * (attn @ w_attn_branch[layer])
                  + jax.nn.sigmoid(g_ssm) * (ssm @ w_ssm_branch[layer]))
        x = x + merged @ w_out[layer]
        h2 = rmsnorm(x, norm2_g[layer])
        x = x + (jax.nn.silu(h2 @ w_ffn_gate[layer]) * (h2 @ w_ffn_up[layer])) @ w_ffn_down[layer]
    return rmsnorm(x, norm_f_g)
```

```cpp
#include <hip/hip_runtime.h>
#include <hip/hip_cooperative_groups.h>
#include <cstdio>
#include <cstdint>
namespace cg = cooperative_groups;

#ifndef MK_RANGES
#define MK_RANGES {0, 11}
#endif
#ifndef MK_PER_PHASE
#define MK_PER_PHASE 0
#endif

#define LAS __attribute__((address_space(3)))
typedef unsigned short bf16_t;
typedef short bf16x8 __attribute__((ext_vector_type(8)));
typedef float f32x4 __attribute__((ext_vector_type(4)));
typedef float f32x2 __attribute__((ext_vector_type(2)));
typedef float f32x16 __attribute__((ext_vector_type(16)));
typedef unsigned u32x4 __attribute__((ext_vector_type(4)));
typedef unsigned u32x2 __attribute__((ext_vector_type(2)));
typedef __bf16 bf2_t __attribute__((ext_vector_type(2)));
#define DI __device__ __forceinline__

constexpr int NTOK = 32768, DM = 1024, SEQ = 4096, INC = 3328, DFF = 2816;
constexpr int CH = 32;
constexpr int NROW = NTOK / CH;
constexpr int UCK = 768;
constexpr float RMS_EPS = 1e-6f;

constexpr size_t MiB = 1u << 20;
constexpr size_t WS_WINT = 0;
constexpr size_t WS_SWIN = WS_WINT + (size_t)INC * DM * 2;
constexpr size_t WS_BT2 = WS_SWIN + (size_t)32 * 256 * 512 * 2;
constexpr size_t WS_WGLUT = WS_BT2 + (size_t)32 * 512 * 768 * 2;
constexpr size_t WS_BTCAT = WS_WGLUT + (size_t)512 * 512 * 2;
constexpr size_t WS_WOT = WS_BTCAT + (size_t)DM * DM * 2;
constexpr size_t WS_BTFFN = WS_WOT + (size_t)DM * DM * 2;
constexpr size_t WS_WDT = WS_BTFFN + (size_t)2 * DFF * DM * 2;
constexpr size_t WS_ROPE = WS_WDT + (size_t)DM * DFF * 2;
constexpr size_t WS_LAMT = WS_ROPE + (size_t)SEQ * 16 * 4;
constexpr size_t WS_SSQ1 = WS_LAMT + (size_t)32 * 2 * 64 * 2 * 4;
constexpr size_t WS_SSQ2 = WS_SSQ1 + (size_t)NTOK * 16 * 4;
constexpr size_t WS_BAR = WS_SSQ2 + (size_t)NTOK * 16 * 4;
constexpr size_t WS_WEND = WS_BAR + 4 * 3456 * 4 + 1024;
static_assert(WS_WEND <= 72 * MiB, "weights region");
constexpr size_t WS_H1 = 72 * MiB;
constexpr size_t WS_AS = WS_H1;
constexpr size_t WS_Q = 136 * MiB;
constexpr size_t WS_YG = WS_Q;
constexpr size_t WS_K = 168 * MiB;
constexpr size_t WS_V = 176 * MiB;
constexpr size_t WS_UCAT = 184 * MiB;
constexpr size_t WS_MG = WS_UCAT;
constexpr size_t WS_F = 232 * MiB;
constexpr size_t WS_GA = 264 * MiB;
constexpr size_t WS_GS = 328 * MiB;
constexpr size_t WS_XB = 392 * MiB;
constexpr size_t WS_HMID = 72 * MiB;
constexpr size_t WS_END = 456 * MiB;
static_assert(WS_HMID + (size_t)NTOK * DFF * 2 <= WS_GA, "hmid overlay");

constexpr int LDS_BYTES = 147456;

DI unsigned pk_bf16(float lo, float hi) { f32x2 v = {lo, hi}; bf2_t b = __builtin_convertvector(v, bf2_t); return __builtin_bit_cast(unsigned, b); }
DI float bf_lo(unsigned u) { return __uint_as_float(u << 16); }
DI float bf_hi(unsigned u) { return __uint_as_float(u & 0xffff0000u); }
DI u32x4 pack8(const f32x4& a, const f32x4& b) { u32x4 w; w.x = pk_bf16(a[0], a[1]); w.y = pk_bf16(a[2], a[3]); w.z = pk_bf16(b[0], b[1]); w.w = pk_bf16(b[2], b[3]); return w; }
DI void unpack8(const u32x4& w, f32x4& a, f32x4& b) { a[0] = bf_lo(w.x); a[1] = bf_hi(w.x); a[2] = bf_lo(w.y); a[3] = bf_hi(w.y); b[0] = bf_lo(w.z); b[1] = bf_hi(w.z); b[2] = bf_lo(w.w); b[3] = bf_hi(w.w); }
DI float sigmoid_f(float x) { return __builtin_amdgcn_rcpf(1.0f + __expf(-x)); }
DI float gelu_tanh(float x) { const float t = 1.5957691216f * (x + 0.044715f * x * x * x); return x * sigmoid_f(t); }
DI float wave_sum(float v) {
#pragma unroll
    for (int o = 1; o < 64; o <<= 1) v += __shfl_xor(v, o);
    return v;
}

namespace pg8 {
constexpr int BM = 256, BK = 64, HALF = 128, HTB = HALF * BK * 2, NXCD = 8, WGM = 8;
DI int lds_byte(int r, int c) { const int st = (r >> 4) * 2 + (c >> 5), rr = r & 15, cc = c & 31, ob = rr * 64 + cc * 2; return st * 1024 + (ob ^ (((ob >> 9) & 1) << 5)); }
DI void stage_rc(int b, int& R, int& C) { const int st = b / 1024, sb = b % 1024, swz = sb ^ (((sb >> 9) & 1) << 5); R = (st >> 1) * 16 + swz / 64; C = (st & 1) * 32 + (swz % 64) / 2; }
DI int perm32(int rho) { const int n = rho >> 4, i = rho & 15; return 8 * (i >> 2) + 4 * n + (i & 3); }

struct Unit { int pm, pn, kh; };
struct Gemm { const bf16_t* A; const bf16_t* Bt; int lda, ldb, K, ksubA; int kofsA, kofsB; };

DI int xcd_remap(int wgid, int nwg) { const int q = nwg / NXCD, r = nwg % NXCD, xcd = wgid % NXCD, off = wgid / NXCD; return (xcd < r ? xcd * (q + 1) : r * (q + 1) + (xcd - r) * q) + off; }
struct StaticOrder {
    int nM, nN, nwg, G, c, pair;
    DI void init(int nM_, int nN_, int G_, int c_, int pair_ = 0) { nM = nM_; nN = nN_; nwg = nM * nN; G = G_; c = c_; pair = pair_; }
    DI bool next(int i, Unit& u) const {
        const long L = (long)(pair ? (i >> 1) : i) * G + c; if (L >= nwg) return false;
        u.kh = pair ? (i & 1) : 0;
        const int wgid = xcd_remap((int)L, nwg);
        const int nig = WGM * nN, gid = wgid / nig, fm = gid * WGM, gsz = (nM - fm) < WGM ? (nM - fm) : WGM;
        u.pm = fm + ((wgid % nig) % gsz); u.pn = (wgid % nig) / gsz; return true;
    }
};
struct GroupOrder {
    int gm, gn, nwg, G, c;
    DI void init(int ngrp, int gm_, int gn_, int G_, int c_) { gm = gm_; gn = gn_; nwg = ngrp * gm * gn; G = G_; c = c_; }
    DI bool next(int i, Unit& u) const {
        const long L = (long)i * G + c; if (L >= nwg) return false;
        u.kh = 0;
        const int wgid = xcd_remap((int)L, nwg);
        const int per = gm * gn, g = wgid / per, r = wgid % per;
        u.pm = g * gm + (r % gm); u.pn = g * gn + (r / gm); return true;
    }
};

typedef f32x4 Acc[2][2][4][2];

template <class Epi, class Sched>
DI void gemm_phase(LAS unsigned char* lds, const Gemm g, const Sched& S, const Epi& E) {
    const int tid = threadIdx.x, wid = __builtin_amdgcn_readfirstlane(tid >> 6), lane = tid & 63, wr = wid >> 2, wc = wid & 3, fr = lane & 15, fq = lane >> 4;
    const int K = g.K, nt = K / BK;
    unsigned voffA[2], voffB[2];
#pragma unroll
    for (int i = 0; i < 2; ++i) { int R, C; stage_rc(tid * 16 + i * 8192, R, C); const int Rb = (R & ~31) + perm32(R & 31);
        voffA[i] = (unsigned)(R * g.lda + (C >> 4) * g.ksubA + (C & 15)) * 2u; voffB[i] = (unsigned)(Rb * g.ldb + C) * 2u; }
    const size_t kstepA = (size_t)g.ksubA * 8, kstepB = (size_t)(BK * 2);
    const size_t hstepA = (size_t)HALF * g.lda * 2, hstepB = (size_t)HALF * g.ldb * 2;
    const size_t tstepA = 2 * hstepA, tstepB = 2 * hstepB;
    const unsigned ldsw = (unsigned)wid * 1024u;
    const int aoff = lds_byte(wr * 64 + fr, fq * 8), boff = lds_byte(wc * 32 + fr, fq * 8);
#define PG8_SA(b, h) (((b) * 2 + (h)) * HTB)
#define PG8_SB(b, h) ((4 + (b) * 2 + (h)) * HTB)
#define PG8_STAGE(bufoff, gbase, voff) do { _Pragma("unroll") for (int _i = 0; _i < 2; ++_i) \
        __builtin_amdgcn_global_load_lds((const unsigned*)((const char*)(gbase) + (voff)[_i]), (LAS unsigned*)(lds + (bufoff) + ldsw + _i * 8192), 16, 0, 0); } while (0)
#define PG8_LDA(dst, b, h) do { _Pragma("unroll") for (int m = 0; m < 4; ++m) _Pragma("unroll") for (int k = 0; k < 2; ++k) dst[m][k] = *(const LAS bf16x8*)(lds + PG8_SA(b, h) + aoff + m * 2048 + k * 1024); } while (0)
#define PG8_LDB(dst, b, h) do { _Pragma("unroll") for (int n = 0; n < 2; ++n) _Pragma("unroll") for (int k = 0; k < 2; ++k) dst[n][k] = *(const LAS bf16x8*)(lds + PG8_SB(b, h) + boff + n * 2048 + k * 1024); } while (0)
#define PG8_MMA(ai, bj, At, Bt) do { __builtin_amdgcn_s_setprio(1); _Pragma("unroll") for (int m = 0; m < 4; ++m) _Pragma("unroll") for (int n = 0; n < 2; ++n) _Pragma("unroll") for (int k = 0; k < 2; ++k) \
        acc[ai][bj][m][n] = __builtin_amdgcn_mfma_f32_16x16x32_bf16(Bt[n][k], At[m][k], acc[ai][bj][m][n], 0, 0, 0); __builtin_amdgcn_s_setprio(0); } while (0)
#define PG8_WAIT_V(n) asm volatile("s_waitcnt vmcnt(" #n ")" ::: "memory")
#define PG8_WAIT_L(n) asm volatile("s_waitcnt lgkmcnt(" #n ")" ::: "memory")
#define PG8_BAR __builtin_amdgcn_s_barrier()
#define PG8_SCHED __builtin_amdgcn_sched_barrier(0)
    Unit cur, nxt; int ui = 0;
    if (!S.next(0, cur)) return;
    Acc acc;
#pragma unroll
    for (int a = 0; a < 2; ++a)
#pragma unroll
        for (int b = 0; b < 2; ++b)
#pragma unroll
            for (int m = 0; m < 4; ++m)
#pragma unroll
                for (int n = 0; n < 2; ++n) acc[a][b][m][n] = (f32x4){0.f, 0.f, 0.f, 0.f};
    bf16x8 At[4][2], B0[2][2], B1[2][2];
    const char* cA = (const char*)g.A + (size_t)cur.pm * tstepA + (size_t)cur.kh * g.kofsA; const char* cB = (const char*)g.Bt + (size_t)cur.pn * tstepB + (size_t)cur.kh * g.kofsB;
    PG8_STAGE(PG8_SB(0, 0), cB, voffB); PG8_STAGE(PG8_SB(0, 1), cB + hstepB, voffB); PG8_STAGE(PG8_SA(0, 0), cA, voffA); PG8_STAGE(PG8_SA(0, 1), cA + hstepA, voffA);
    if (wr == 1) PG8_BAR;
    PG8_WAIT_V(2); PG8_BAR;
    PG8_STAGE(PG8_SB(1, 0), cB + kstepB, voffB); PG8_STAGE(PG8_SA(1, 0), cA + kstepA, voffA); PG8_STAGE(PG8_SB(1, 1), cB + hstepB + kstepB, voffB);
    PG8_WAIT_V(6); PG8_BAR;
    for (;;) {
        const bool has_next = S.next(ui + 1, nxt);
        const char* nA = has_next ? (const char*)g.A + (size_t)nxt.pm * tstepA + (size_t)nxt.kh * g.kofsA : cA; const char* nB = has_next ? (const char*)g.Bt + (size_t)nxt.pn * tstepB + (size_t)nxt.kh * g.kofsB : cB;
        for (int t = 0; t < nt; t += 2) {
            const bool last = (t == nt - 2);
            const char* a1 = cA + (size_t)(t + 1) * kstepA;
            const char* a2 = last ? nA : cA + (size_t)(t + 2) * kstepA; const char* b2 = last ? nB : cB + (size_t)(t + 2) * kstepB;
            const char* a3 = a2 + kstepA; const char* b3 = b2 + kstepB;
            PG8_LDB(B0, 0, 0); PG8_LDB(B1, 0, 1); PG8_SCHED; PG8_LDA(At, 0, 0); PG8_STAGE(PG8_SA(1, 1), a1 + hstepA, voffA);
            PG8_WAIT_V(8); PG8_WAIT_L(0); PG8_BAR; PG8_MMA(0, 0, At, B0); PG8_MMA(0, 1, At, B1); PG8_BAR; PG8_SCHED;
            PG8_LDA(At, 0, 1); PG8_STAGE(PG8_SB(0, 0), b2, voffB); PG8_STAGE(PG8_SB(0, 1), b2 + hstepB, voffB); PG8_STAGE(PG8_SA(0, 0), a2, voffA);
            PG8_WAIT_V(8); PG8_WAIT_L(0); PG8_BAR; PG8_MMA(1, 0, At, B0); PG8_MMA(1, 1, At, B1); PG8_BAR; PG8_SCHED;
            PG8_LDB(B0, 1, 0); PG8_LDB(B1, 1, 1); PG8_SCHED; PG8_LDA(At, 1, 0); PG8_STAGE(PG8_SA(0, 1), a2 + hstepA, voffA);
            PG8_WAIT_V(8); PG8_WAIT_L(0); PG8_BAR; PG8_MMA(0, 0, At, B0); PG8_MMA(0, 1, At, B1); PG8_BAR; PG8_SCHED;
            PG8_LDA(At, 1, 1); PG8_STAGE(PG8_SB(1, 0), b3, voffB); PG8_STAGE(PG8_SB(1, 1), b3 + hstepB, voffB); PG8_STAGE(PG8_SA(1, 0), a3, voffA);
            PG8_WAIT_V(8); PG8_WAIT_L(0); PG8_BAR; PG8_MMA(1, 0, At, B0); PG8_MMA(1, 1, At, B1); PG8_BAR; PG8_SCHED;
        }
        if (wr == 0) PG8_BAR;
        E(acc, cur, wr, wc, fr, fq);
        if (!has_next) break;
        if (!(Epi::MID > 0 && cur.kh == 0))
#pragma unroll
        for (int a = 0; a < 2; ++a)
#pragma unroll
            for (int b = 0; b < 2; ++b)
#pragma unroll
                for (int m = 0; m < 4; ++m)
#pragma unroll
                    for (int n = 0; n < 2; ++n) acc[a][b][m][n] = (f32x4){0.f, 0.f, 0.f, 0.f};
        cur = nxt; cA = nA; cB = nB; ++ui;
        if (wr == 1) PG8_BAR;
    }
    PG8_WAIT_V(0);
    PG8_BAR;
#undef PG8_SA
#undef PG8_SB
#undef PG8_STAGE
#undef PG8_LDA
#undef PG8_LDB
#undef PG8_MMA
#undef PG8_WAIT_V
#undef PG8_WAIT_L
#undef PG8_BAR
#undef PG8_SCHED
}
}
using pg8::Acc; using pg8::Unit;

struct EpiIn {
    static constexpr int MID = 0;
    bf16_t *Q, *Kb, *Vb, *ucat, *Ga, *Gs; const float* rope;
    DI void operator()(Acc& acc, const Unit& u, int wr, int wc, int fr, int fq) const {
        const int pn = u.pn, row0 = u.pm * 256 + wr * 64 + fr;
#pragma unroll
        for (int ai = 0; ai < 2; ++ai) {
            f32x4 rc[4][4];
            if (pn < 3 && (wc & 1) == 0 && fq < 2) {
#pragma unroll
                for (int m = 0; m < 4; ++m) { const float* cs = rope + (size_t)((row0 + ai * 128 + m * 16) & (SEQ - 1)) * 16;
                    rc[m][0] = *(const f32x4*)cs; rc[m][1] = *(const f32x4*)(cs + 4); rc[m][2] = *(const f32x4*)(cs + 8); rc[m][3] = *(const f32x4*)(cs + 12); }
            } else {
#pragma unroll
                for (int m = 0; m < 4; ++m) { rc[m][0] = rc[m][1] = rc[m][2] = rc[m][3] = (f32x4){0.f, 0.f, 0.f, 0.f}; }
            }
            __builtin_amdgcn_sched_barrier(0);
#pragma unroll
            for (int m = 0; m < 4; ++m) {
                const int row = row0 + ai * 128 + m * 16;
#pragma unroll
                for (int bj = 0; bj < 2; ++bj) {
                    f32x4 v0 = acc[ai][bj][m][0], v1 = acc[ai][bj][m][1];
                    const int col = pn * 256 + bj * 128 + wc * 32 + 8 * fq;
                    if (pn < 3) {
                        const bool is_v = (pn == 2 && bj == 1);
                        if (!is_v && (wc & 1) == 0) {
                            f32x4 p0, p1;
#pragma unroll
                            for (int j = 0; j < 4; ++j) { p0[j] = __shfl_xor(v0[j], 16); p1[j] = __shfl_xor(v1[j], 16); }
                            if (fq < 2) {
                                const f32x4 c0 = rc[m][0], c1 = rc[m][1], s0 = rc[m][2], s1 = rc[m][3];
                                const float sg = fq == 0 ? -1.f : 1.f;
                                v0 = v0 * c0 + sg * (p0 * s0); v1 = v1 * c1 + sg * (p1 * s1);
                            }
                        }
                        if (pn < 2) { v0 = v0 * 0.18033688f; v1 = v1 * 0.18033688f;     *(u32x4*)(Q + (size_t)row * 512 + col) = pack8(v0, v1); }
                        else if (bj == 0) *(u32x4*)(Kb + (size_t)row * 128 + (col - 512)) = pack8(v0, v1);
                        else *(u32x4*)(Vb + (size_t)row * 128 + (col - 640)) = pack8(v0, v1);
                    } else if (pn < 5) {
                        const int cu = col - 768, gi = cu >> 4, hh0 = cu & 15;
                        *(u32x4*)(ucat + ((size_t)gi * NROW + (row >> 5)) * UCK + (row & 31) * 16 + hh0) = pack8(v0, v1);
                    } else if (bj == 0) {
                        const f32x4 a0 = acc[ai][0][m][0], a1 = acc[ai][0][m][1], b0 = acc[ai][1][m][0], b1 = acc[ai][1][m][1];
                        f32x4 r0, r1, g0, g1;
#pragma unroll
                        for (int j = 0; j < 4; ++j) {
                            const float pa0 = 1.0f + __expf(-a0[j]), pa1 = 1.0f + __expf(-a1[j]), pb0 = 1.0f + __expf(-b0[j]), pb1 = 1.0f + __expf(-b1[j]);
                            const float i0 = __builtin_amdgcn_rcpf(pa0 * pb0), i1 = __builtin_amdgcn_rcpf(pa1 * pb1);
                            g0[j] = pa0 * i0; g1[j] = pa1 * i1;
                            r0[j] = pb0 * pb0 * i0; r1[j] = pb1 * pb1 * i1;
                        }
                        const size_t o = (size_t)row * DM + (pn - 5) * 128 + wc * 32 + 8 * fq;
                        *(u32x4*)(Ga + o) = pack8(r0, r1); *(u32x4*)(Gs + o) = pack8(g0, g1);
                    }
                }
            }
        }
    }
};
struct EpiF {
    static constexpr int MID = 0;
    float* F;
    DI void operator()(Acc& acc, const Unit& u, int wr, int wc, int fr, int fq) const {
        const int row0 = u.pm * 256 + wr * 64 + fr;
#pragma unroll
        for (int ai = 0; ai < 2; ++ai)
#pragma unroll
            for (int m = 0; m < 4; ++m)
#pragma unroll
                for (int bj = 0; bj < 2; ++bj) {
                    float* p = F + (size_t)(row0 + ai * 128 + m * 16) * 256 + bj * 128 + wc * 32 + 8 * fq;
                    *(f32x4*)p = acc[ai][bj][m][0]; *(f32x4*)(p + 4) = acc[ai][bj][m][1];
                }
    }
};
struct EpiY {
    static constexpr int MID = 0;
    bf16_t* yg;
    DI void operator()(Acc& acc, const Unit& u, int wr, int wc, int fr, int fq) const {
        const int row0 = u.pm * 256 + wr * 64 + fr, colt = (u.pn & 1) * 256 + wc * 32 + 8 * fq;
#pragma unroll
        for (int ai = 0; ai < 2; ++ai)
#pragma unroll
            for (int m = 0; m < 4; ++m)
#pragma unroll
                for (int bj = 0; bj < 2; ++bj) {
                    f32x4 v0 = acc[ai][bj][m][0], v1 = acc[ai][bj][m][1];
#pragma unroll
                    for (int j = 0; j < 4; ++j) { v0[j] = gelu_tanh(v0[j]); v1[j] = gelu_tanh(v1[j]); }
                    *(u32x4*)(yg + (size_t)(row0 + ai * 128 + m * 16) * 512 + colt + bj * 128) = pack8(v0, v1);
                }
    }
};
struct EpiGlu {
    static constexpr int MID = 0;
    const bf16_t* yg; bf16_t* AS;
    DI void operator()(Acc& acc, const Unit& u, int wr, int wc, int fr, int fq) const {
        const int row0 = u.pm * 256 + wr * 64 + fr;
        u32x4 yv[2][4][2];
#pragma unroll
        for (int ai = 0; ai < 2; ++ai)
#pragma unroll
            for (int m = 0; m < 4; ++m)
#pragma unroll
                for (int bj = 0; bj < 2; ++bj) { const int col = u.pn * 256 + bj * 128 + wc * 32 + 8 * fq;
                    yv[ai][m][bj] = *(const u32x4*)(yg + (size_t)(col >> 4) * (NTOK * 16) + (size_t)(row0 + ai * 128 + m * 16) * 16 + (col & 15)); }
        __builtin_amdgcn_sched_barrier(0);
#pragma unroll
        for (int ai = 0; ai < 2; ++ai)
#pragma unroll
            for (int m = 0; m < 4; ++m) {
                const int row = row0 + ai * 128 + m * 16;
#pragma unroll
                for (int bj = 0; bj < 2; ++bj) {
                    const int col = u.pn * 256 + bj * 128 + wc * 32 + 8 * fq;
                    const u32x4 yw = yv[ai][m][bj];
                    f32x4 y0, y1; unpack8(yw, y0, y1);
                    f32x4 v0 = acc[ai][bj][m][0], v1 = acc[ai][bj][m][1];
#pragma unroll
                    for (int j = 0; j < 4; ++j) { v0[j] = y0[j] * sigmoid_f(v0[j]); v1[j] = y1[j] * sigmoid_f(v1[j]); }
                    *(u32x4*)(AS + (size_t)row * DM + 512 + col) = pack8(v0, v1);
                }
            }
    }
};
struct EpiMerge {
    static constexpr int MID = 8;
    const bf16_t *Ga, *Gs; bf16_t* Mg;
    DI void mid(Acc& acc, const Unit& u, int wr, int wc, int fr, int fq) const {
        const char* base = (const char*)Ga + ((size_t)u.pm * 256 * DM + (size_t)u.pn * 256) * 2;
        const unsigned lo = (unsigned)((wr * 64 + fr) * DM + wc * 32 + 8 * fq) * 2u;
        u32x4 w[2][4][2];
#pragma unroll
        for (int ai = 0; ai < 2; ++ai)
#pragma unroll
            for (int m = 0; m < 4; ++m)
#pragma unroll
                for (int bj = 0; bj < 2; ++bj) w[ai][m][bj] = *(const u32x4*)(base + (size_t)((ai * 128 + m * 16) * DM + bj * 128) * 2 + lo);
        __builtin_amdgcn_sched_barrier(0);
#pragma unroll
        for (int ai = 0; ai < 2; ++ai)
#pragma unroll
            for (int m = 0; m < 4; ++m)
#pragma unroll
                for (int bj = 0; bj < 2; ++bj) { f32x4 a0, a1; unpack8(w[ai][m][bj], a0, a1); acc[ai][bj][m][0] *= a0; acc[ai][bj][m][1] *= a1; }
    }
    DI void operator()(Acc& acc, const Unit& u, int wr, int wc, int fr, int fq) const {
        if (u.kh == 0) { mid(acc, u, wr, wc, fr, fq); return; }
        const int row0 = u.pm * 256 + wr * 64 + fr, col0 = u.pn * 256 + wc * 32 + 8 * fq;
        u32x4 w[2][4][2];
#pragma unroll
        for (int ai = 0; ai < 2; ++ai)
#pragma unroll
            for (int m = 0; m < 4; ++m)
#pragma unroll
                for (int bj = 0; bj < 2; ++bj) w[ai][m][bj] = *(const u32x4*)(Gs + (size_t)(row0 + ai * 128 + m * 16) * DM + col0 + bj * 128);
        __builtin_amdgcn_sched_barrier(0);
#pragma unroll
        for (int ai = 0; ai < 2; ++ai)
#pragma unroll
            for (int m = 0; m < 4; ++m)
#pragma unroll
                for (int bj = 0; bj < 2; ++bj) {
                    const size_t o = (size_t)(row0 + ai * 128 + m * 16) * DM + col0 + bj * 128;
                    f32x4 s0, s1; unpack8(w[ai][m][bj], s0, s1);
                    f32x4 v0 = acc[ai][bj][m][0], v1 = acc[ai][bj][m][1];
#pragma unroll
                    for (int j = 0; j < 4; ++j) { v0[j] *= fmaxf(s0[j], 1e-30f); v1[j] *= fmaxf(s1[j], 1e-30f); }
                    *(u32x4*)(Mg + o) = pack8(v0, v1);
                }
    }
};
template <bool IN_BF> struct EpiRes {
    static constexpr int MID = 0;
    const float* xi; const bf16_t* xib; bf16_t* xb; float* ssq;
    DI void operator()(Acc& acc, const Unit& u, int wr, int wc, int fr, int fq) const {
        const int row0 = u.pm * 256 + wr * 64 + fr, col0 = u.pn * 256 + wc * 32 + 8 * fq;
#pragma unroll
        for (int ai = 0; ai < 2; ++ai) {
            f32x4 xv[4][2][2];
            if (IN_BF) {
                u32x4 w[4][2];
#pragma unroll
                for (int m = 0; m < 4; ++m)
#pragma unroll
                    for (int bj = 0; bj < 2; ++bj) w[m][bj] = *(const u32x4*)(xib + (size_t)(row0 + ai * 128 + m * 16) * DM + col0 + bj * 128);
                __builtin_amdgcn_sched_barrier(0);
#pragma unroll
                for (int m = 0; m < 4; ++m)
#pragma unroll
                    for (int bj = 0; bj < 2; ++bj) unpack8(w[m][bj], xv[m][bj][0], xv[m][bj][1]);
            } else {
#pragma unroll
                for (int m = 0; m < 4; ++m)
#pragma unroll
                    for (int bj = 0; bj < 2; ++bj) { const float* p = xi + (size_t)(row0 + ai * 128 + m * 16) * DM + col0 + bj * 128; xv[m][bj][0] = *(const f32x4*)p; xv[m][bj][1] = *(const f32x4*)(p + 4); }
                __builtin_amdgcn_sched_barrier(0);
            }
#pragma unroll
            for (int m = 0; m < 4; ++m) {
                const int row = row0 + ai * 128 + m * 16; float ss = 0.f;
#pragma unroll
                for (int bj = 0; bj < 2; ++bj) {
                    const size_t o = (size_t)row * DM + col0 + bj * 128;
                    const f32x4 v0 = xv[m][bj][0] + acc[ai][bj][m][0], v1 = xv[m][bj][1] + acc[ai][bj][m][1];
                    *(u32x4*)(xb + o) = pack8(v0, v1);
                    ss += (v0[0] * v0[0] + v0[1] * v0[1]) + (v0[2] * v0[2] + v0[3] * v0[3]) + (v1[0] * v1[0] + v1[1] * v1[1]) + (v1[2] * v1[2] + v1[3] * v1[3]);
                }
                ss += __shfl_xor(ss, 16); ss += __shfl_xor(ss, 32);
                if (fq == 0) ssq[(size_t)row * 16 + u.pn * 4 + wc] = ss;
            }
        }
    }
};
struct EpiFfn1 {
    static constexpr int MID = 0;
    const float* ssq; bf16_t* hmid;
    DI void operator()(Acc& acc, const Unit& u, int wr, int wc, int fr, int fq) const {
        const int row0 = u.pm * 256 + wr * 64 + fr, col0 = u.pn * 128 + wc * 32 + 8 * fq;
        f32x4 qv[2][4];
#pragma unroll
        for (int ai = 0; ai < 2; ++ai)
#pragma unroll
            for (int m = 0; m < 4; ++m) qv[ai][m] = *((const f32x4*)(ssq + (size_t)(row0 + ai * 128 + m * 16) * 16) + fq);
        __builtin_amdgcn_sched_barrier(0);
#pragma unroll
        for (int ai = 0; ai < 2; ++ai)
#pragma unroll
            for (int m = 0; m < 4; ++m) {
                const int row = row0 + ai * 128 + m * 16;
                float tot = (qv[ai][m][0] + qv[ai][m][1]) + (qv[ai][m][2] + qv[ai][m][3]);
                tot += __shfl_xor(tot, 16); tot += __shfl_xor(tot, 32);
                const float rs = 1.0f / sqrtf(tot * (1.0f / DM) + RMS_EPS);
                f32x4 v0, v1;
#pragma unroll
                for (int j = 0; j < 4; ++j) {
                    const float g0 = rs * acc[ai][0][m][0][j], g1 = rs * acc[ai][0][m][1][j];
                    v0[j] = g0 * sigmoid_f(g0) * (rs * acc[ai][1][m][0][j]); v1[j] = g1 * sigmoid_f(g1) * (rs * acc[ai][1][m][1][j]);
                }
                *(u32x4*)(hmid + (size_t)row * DFF + col0) = pack8(v0, v1);
            }
    }
};

DI void tr_item(const float* W, int K, int N, bf16_t* WT, int ldt, int koff, int mode, const float* scale, LAS float* scr, int item, int lane) {
    const int nblk = N / 32, kb = item / nblk, nb = item % nblk, k0 = 64 * kb, n0 = 32 * nb;
    float wv[32];
#pragma unroll
    for (int i = 0; i < 32; ++i) { const int kk = 2 * i + (lane >> 5); wv[i] = __builtin_nontemporal_load(W + (size_t)(k0 + kk) * N + n0 + (lane & 31)); }
    float sv = 1.0f; if (scale) sv = scale[k0 + lane];
#pragma unroll
    for (int i = 0; i < 32; ++i) { const int kk = 2 * i + (lane >> 5); const float w = wv[i] * __shfl(sv, kk); scr[kk * 33 + (lane & 31)] = w; }
    asm volatile("s_waitcnt lgkmcnt(0)" ::: "memory");
    const int c = lane & 7;
#pragma unroll
    for (int j = 0; j < 4; ++j) { const int n = (lane >> 3) + 8 * j; const LAS float* s = scr + (8 * c) * 33 + n;
        u32x4 o; o.x = pk_bf16(s[0 * 33], s[1 * 33]); o.y = pk_bf16(s[2 * 33], s[3 * 33]); o.z = pk_bf16(s[4 * 33], s[5 * 33]); o.w = pk_bf16(s[6 * 33], s[7 * 33]);
        const int ng = n0 + n; int rowd;
        if (mode == 0) rowd = ng; else if (mode == 3) { if (ng < 1280) rowd = ng; else { const int n2 = ng - 1280, cg2 = n2 & 1023; rowd = 1280 + (cg2 >> 7) * 256 + (n2 >= 1024 ? 128 : 0) + (cg2 & 127); } }
        else rowd = (ng >> 7) * 256 + (mode == 2 ? 128 : 0) + (ng & 127);
        *(u32x4*)(WT + (size_t)rowd * ldt + koff + k0 + 8 * c) = o; }
    asm volatile("s_waitcnt lgkmcnt(0)" ::: "memory");
}

DI void ssm_tables(LAS unsigned char* lds, int g, int hf, const float* lam_re, const float* lam_im, const float* log_dt, const float* b_re, const float* b_im,
                   const float* c_re, const float* c_im, const float* dvec, bf16_t* Win, bf16_t* Bt2, float* lamT) {
    LAS float* pw = (LAS float*)lds;
    LAS float* bb = pw + 8448;
    LAS float* cc = bb + 4096;
    LAS float* Kt = cc + 2048;
    LAS float* coef = Kt + 8192;
    const int tid = threadIdx.x;
    if (tid < 128) {
        const int dir = tid >> 6, p = tid & 63; const int gi = (dir * 32 + g) * 64 + p;
        const float lr = lam_re[gi], li = lam_im[gi], dt = expf(log_dt[dir * 32 + g]);
        const float mag = expf(lr * dt); float sn, cs; sincosf(li * dt, &sn, &cs);
        const float ar = mag * cs, ai = mag * sn;
        { const float nr = ar - 1.0f, ni = ai, den = lr * lr + li * li;
          coef[(dir * 64 + p) * 2] = (nr * lr + ni * li) / den; coef[(dir * 64 + p) * 2 + 1] = (ni * lr - nr * li) / den; }
        float wr_ = 1.f, wi_ = 0.f;
        for (int tau = 0; tau <= 32; ++tau) {
            pw[((dir * 64 + p) * 33 + tau) * 2] = wr_; pw[((dir * 64 + p) * 33 + tau) * 2 + 1] = wi_;
            if (tau == 32 && hf == 0) { lamT[((g * 2 + dir) * 64 + p) * 2] = wr_; lamT[((g * 2 + dir) * 64 + p) * 2 + 1] = wi_; }
            const float nr = wr_ * ar - wi_ * ai, ni = wr_ * ai + wi_ * ar; wr_ = nr; wi_ = ni;
        }
    }
    __syncthreads();
    for (int idx = tid; idx < 2048; idx += 512) {
        const int dir = idx >> 10, p = (idx >> 4) & 63, h = idx & 15; const int gi = ((dir * 32 + g) * 64 + p) * 16 + h;
        const float br = b_re[gi], bi = b_im[gi], cr = coef[(dir * 64 + p) * 2], ci = coef[(dir * 64 + p) * 2 + 1];
        bb[idx * 2] = cr * br - ci * bi; bb[idx * 2 + 1] = cr * bi + ci * br;
    }
    for (int idx = tid; idx < 1024; idx += 512) {
        const int hh = idx >> 6, p = idx & 63;
        cc[(p * 16 + hh) * 2] = c_re[g * 1024 + idx]; cc[(p * 16 + hh) * 2 + 1] = c_im[g * 1024 + idx];
    }
    __syncthreads();
    {
        const int dir = tid >> 8, tau = (tid >> 3) & 31, hl = tid & 7, hh = 8 * hf + hl;
        float a[16];
#pragma unroll
        for (int h = 0; h < 16; ++h) a[h] = 0.f;
        for (int p = 0; p < 64; p += 2) {
            f32x2 cv[2], pv[2]; f32x4 bv[2][8];
#pragma unroll
            for (int q = 0; q < 2; ++q) { cv[q] = *(const LAS f32x2*)(cc + ((p + q) * 16 + hh) * 2); pv[q] = *(const LAS f32x2*)(pw + ((dir * 64 + p + q) * 33 + tau) * 2);
                const LAS f32x4* bp = (const LAS f32x4*)(bb + (dir * 64 + p + q) * 32);
#pragma unroll
                for (int h2 = 0; h2 < 8; ++h2) bv[q][h2] = bp[h2]; }
            __builtin_amdgcn_sched_barrier(0);
#pragma unroll
            for (int q = 0; q < 2; ++q) {
                const float zr = cv[q][0] * pv[q][0] - cv[q][1] * pv[q][1], zi = cv[q][0] * pv[q][1] + cv[q][1] * pv[q][0];
#pragma unroll
                for (int h2 = 0; h2 < 8; ++h2) { a[2 * h2] += zr * bv[q][h2][0] - zi * bv[q][h2][1]; a[2 * h2 + 1] += zr * bv[q][h2][2] - zi * bv[q][h2][3]; }
            }
        }
#pragma unroll
        for (int h = 0; h < 16; ++h) Kt[((dir * 32 + tau) * 8 + hl) * 16 + h] = a[h];
    }
    __syncthreads();
    for (int idx = tid; idx < 8192; idx += 512) {
        const int s = idx & 31, rl = idx >> 5, t = rl >> 3, hl = rl & 7, hh = 8 * hf + hl, row = t * 16 + hh;
        float v[16];
        if (t > s) {
#pragma unroll
            for (int h = 0; h < 16; ++h) v[h] = Kt[(((t - s)) * 8 + hl) * 16 + h];
        } else if (t < s) {
#pragma unroll
            for (int h = 0; h < 16; ++h) v[h] = Kt[((32 + (s - t)) * 8 + hl) * 16 + h];
        } else {
            const float dd = dvec[g * 16 + hh];
#pragma unroll
            for (int h = 0; h < 16; ++h) v[h] = Kt[(hl) * 16 + h] + Kt[((32) * 8 + hl) * 16 + h] + (h == hh ? dd : 0.f);
        }
        u32x4 o0, o1;
        o0.x = pk_bf16(v[0], v[1]); o0.y = pk_bf16(v[2], v[3]); o0.z = pk_bf16(v[4], v[5]); o0.w = pk_bf16(v[6], v[7]);
        o1.x = pk_bf16(v[8], v[9]); o1.y = pk_bf16(v[10], v[11]); o1.z = pk_bf16(v[12], v[13]); o1.w = pk_bf16(v[14], v[15]);
        bf16_t* d = Bt2 + ((size_t)(g * 512 + row)) * UCK + s * 16;
        *(u32x4*)d = o0; *(u32x4*)(d + 8) = o1;
    }
    for (int idx = tid; idx < 256 * 32; idx += 512) {
        const int c8 = idx & 31, rl = idx >> 5, t = rl >> 3, hl = rl & 7, hh = 8 * hf + hl, row = t * 16 + hh;
        const int col = c8 * 8, dir = col >> 7, ri = (col >> 6) & 1, p0 = col & 63;
        const int e = dir ? (CH - t) : (t + 1);
        float v[8];
#pragma unroll
        for (int q = 0; q < 8; ++q) {
            const f32x2 cv = *(const LAS f32x2*)(cc + ((p0 + q) * 16 + hh) * 2), pv = *(const LAS f32x2*)(pw + ((dir * 64 + p0 + q) * 33 + e) * 2);
            v[q] = ri ? -(cv[0] * pv[1] + cv[1] * pv[0]) : (cv[0] * pv[0] - cv[1] * pv[1]);
        }
        u32x4 o; o.x = pk_bf16(v[0], v[1]); o.y = pk_bf16(v[2], v[3]); o.z = pk_bf16(v[4], v[5]); o.w = pk_bf16(v[6], v[7]);
        *(u32x4*)(Bt2 + ((size_t)(g * 512 + row)) * UCK + 512 + col) = o;
    }
    for (int idx = tid; idx < 4096; idx += 512) {
        const int s = idx & 31, cl = idx >> 5, dir = cl >> 6, ri = (cl >> 5) & 1, p = 32 * hf + (cl & 31), comp = dir * 128 + ri * 64 + p;
        const int e = dir ? s : (CH - 1 - s);
        const float pr = pw[((dir * 64 + p) * 33 + e) * 2], pi = pw[((dir * 64 + p) * 33 + e) * 2 + 1];
        const LAS float* bp = bb + (dir * 64 + p) * 32;
        float v[16];
#pragma unroll
        for (int h = 0; h < 16; ++h) { const float br = bp[2 * h], bi = bp[2 * h + 1]; v[h] = ri ? (pr * bi + pi * br) : (pr * br - pi * bi); }
        u32x4 o0, o1;
        o0.x = pk_bf16(v[0], v[1]); o0.y = pk_bf16(v[2], v[3]); o0.z = pk_bf16(v[4], v[5]); o0.w = pk_bf16(v[6], v[7]);
        o1.x = pk_bf16(v[8], v[9]); o1.y = pk_bf16(v[10], v[11]); o1.z = pk_bf16(v[12], v[13]); o1.w = pk_bf16(v[14], v[15]);
        bf16_t* d = Win + ((size_t)(g * 256 + comp)) * 512 + s * 16;
        *(u32x4*)d = o0; *(u32x4*)(d + 8) = o1;
    }
    __syncthreads();
}

#define MFMA32(a, b, c) __builtin_amdgcn_mfma_f32_32x32x16_bf16((a), (b), (c), 0, 0, 0)
DI void attn_phase(LAS unsigned char* lds, const bf16_t* Q, const bf16_t* Kb, const bf16_t* Vb, bf16_t* AS, const float* sink, int u0, int u1) {
    constexpr int KS = 72, VS = 324, NKEY = 320;
    const int tid = threadIdx.x, lane = tid & 63, wid = __builtin_amdgcn_readfirstlane(tid >> 6), r32 = lane & 31, hi = lane >> 5;
    LAS bf16_t* Kl = (LAS bf16_t*)lds; LAS bf16_t* Vl = (LAS bf16_t*)(lds + NKEY * KS * 2);
    u32x4 kreg[5], vreg[5]; bf16x8 qreg[4];
#define ATT_PREFETCH(un) do { const int kvh_ = (un) & 1, qb_ = ((un) >> 1) & 63, b_ = (un) >> 7; _Pragma("unroll") for (int it = 0; it < 5; ++it) { const int idx = tid + 512 * it, key = idx >> 3, piece = idx & 7, kpos = qb_ * 64 - 128 + key; \
        kreg[it] = (u32x4){0u, 0u, 0u, 0u}; vreg[it] = (u32x4){0u, 0u, 0u, 0u}; \
        if (kpos >= 0 && kpos < SEQ) { const size_t base = (size_t)(b_ * SEQ + kpos) * 128 + kvh_ * 64 + piece * 8; kreg[it] = *(const u32x4*)(Kb + base); vreg[it] = *(const u32x4*)(Vb + base); } } \
        { const size_t qrow_ = (size_t)(b_ * SEQ + qb_ * 64 + (wid & 1) * 32 + r32); const int hq_ = kvh_ * 4 + (wid >> 1); \
          _Pragma("unroll") for (int ds = 0; ds < 4; ++ds) qreg[ds] = *(const bf16x8*)(Q + qrow_ * 512 + hq_ * 64 + ds * 16 + hi * 8); } } while (0)
    if (u0 < u1) ATT_PREFETCH(u0);
    for (int unit = u0; unit < u1; ++unit) {
        const int kvh = unit & 1, qb = (unit >> 1) & 63, b = unit >> 7;
        const int q0 = qb * 64, key0 = q0 - 128;
        __syncthreads();
#pragma unroll
        for (int it = 0; it < 5; ++it) {
            const int idx = tid + 512 * it, key = idx >> 3, piece = idx & 7;
            const u32x4 kv = kreg[it], vv = vreg[it];
            *(LAS u32x4*)(Kl + key * KS + piece * 8) = kv;
            LAS bf16_t* vp = Vl + (piece * 8) * VS + key;
            vp[0 * VS] = (bf16_t)(vv.x & 0xffffu); vp[1 * VS] = (bf16_t)(vv.x >> 16); vp[2 * VS] = (bf16_t)(vv.y & 0xffffu); vp[3 * VS] = (bf16_t)(vv.y >> 16);
            vp[4 * VS] = (bf16_t)(vv.z & 0xffffu); vp[5 * VS] = (bf16_t)(vv.z >> 16); vp[6 * VS] = (bf16_t)(vv.w & 0xffffu); vp[7 * VS] = (bf16_t)(vv.w >> 16);
        }
        __syncthreads();
        bf16x8 qf[4];
#pragma unroll
        for (int ds = 0; ds < 4; ++ds) qf[ds] = qreg[ds];
        if (unit + 1 < u1) ATT_PREFETCH(unit + 1);
        const int hq = kvh * 4 + (wid >> 1), qh = wid & 1;
        const int qmin = q0 + qh * 32, qmax = qmin + 31;
        const int qpos = qmin + r32; const size_t qrow = (size_t)(b * SEQ + qpos);
        float mrun = sink[hq] * 1.44269504f, lrun = 1.0f;
        f32x16 o0, o1;
#pragma unroll
        for (int r = 0; r < 16; ++r) { o0[r] = 0.f; o1[r] = 0.f; }
        for (int kt = 0; kt < 5; ++kt) {
            f32x16 s0, s1;
            const int ks0 = key0 + kt * 64, ks1 = ks0 + 32;
            const int st0 = (ks0 + 31 < qmin - 128 || ks0 > qmax + 128 || ks0 + 31 < 0 || ks0 >= SEQ) ? 0 : ((ks0 >= qmax - 128 && ks0 + 31 <= qmin + 128 && ks0 >= 0 && ks0 + 31 < SEQ) ? 1 : 2);
            const int st1 = (ks1 + 31 < qmin - 128 || ks1 > qmax + 128 || ks1 + 31 < 0 || ks1 >= SEQ) ? 0 : ((ks1 >= qmax - 128 && ks1 + 31 <= qmin + 128 && ks1 >= 0 && ks1 + 31 < SEQ) ? 1 : 2);
            float mx = mrun;
            bf16x8 kfa[4], kfb[4]; u32x2 vlo[4][2], vhi[4][2];
#pragma unroll
            for (int ds = 0; ds < 4; ++ds) { kfa[ds] = *(const LAS bf16x8*)(Kl + (kt * 64 + r32) * KS + ds * 16 + hi * 8); kfb[ds] = *(const LAS bf16x8*)(Kl + (kt * 64 + 32 + r32) * KS + ds * 16 + hi * 8); }
#pragma unroll
            for (int j = 0; j < 4; ++j) { const int kk = kt * 64 + (j >> 1) * 32 + (j & 1) * 16 + 4 * hi;
                vlo[j][0] = *(const LAS u32x2*)(Vl + (r32) * VS + kk); vhi[j][0] = *(const LAS u32x2*)(Vl + (r32) * VS + kk + 8);
                vlo[j][1] = *(const LAS u32x2*)(Vl + (32 + r32) * VS + kk); vhi[j][1] = *(const LAS u32x2*)(Vl + (32 + r32) * VS + kk + 8); }
            __builtin_amdgcn_sched_barrier(0);
#define ATT_SUB(sv, stv, kfx) \
            if (stv == 0) { _Pragma("unroll") for (int r = 0; r < 16; ++r) sv[r] = -1e30f; } \
            else { \
                _Pragma("unroll") for (int r = 0; r < 16; ++r) sv[r] = 0.f; \
                _Pragma("unroll") for (int ds = 0; ds < 4; ++ds) sv = MFMA32(kfx[ds], qf[ds], sv); \
                if (stv == 2) { const int kb_ = key0 + kt * 64 + ((&kfx[0] == &kfb[0]) ? 32 : 0) + 4 * hi; \
                    _Pragma("unroll") for (int r = 0; r < 16; ++r) { const int kp = kb_ + (r & 3) + 8 * (r >> 2); const int d = qpos - kp; \
                        const bool ok = (d <= 128) && (d >= -128) && (kp >= 0) && (kp < SEQ); sv[r] = ok ? sv[r] : -1e30f; } } \
                _Pragma("unroll") for (int r = 0; r < 16; ++r) mx = fmaxf(mx, sv[r]); \
            }
            ATT_SUB(s0, st0, kfa)
            ATT_SUB(s1, st1, kfb)
#undef ATT_SUB
            mx = fmaxf(mx, __shfl_xor(mx, 32));
            const float alpha = __builtin_amdgcn_exp2f(mrun - mx); mrun = mx;
            float sum = 0.f;
#pragma unroll
            for (int r = 0; r < 16; ++r) { s0[r] = __builtin_amdgcn_exp2f(s0[r] - mx); s1[r] = __builtin_amdgcn_exp2f(s1[r] - mx); sum += s0[r] + s1[r]; }
            sum += __shfl_xor(sum, 32);
            lrun = lrun * alpha + sum;
            if (__builtin_amdgcn_ballot_w64(alpha != 1.0f) != 0ull) {
#pragma unroll
                for (int r = 0; r < 16; ++r) { o0[r] *= alpha; o1[r] *= alpha; }
            }
#pragma unroll
            for (int j = 0; j < 4; ++j) {
                if ((j < 2 ? st0 : st1) == 0) continue;
                u32x4 pw4;
                if (j < 2) { pw4.x = pk_bf16(s0[8 * (j & 1) + 0], s0[8 * (j & 1) + 1]); pw4.y = pk_bf16(s0[8 * (j & 1) + 2], s0[8 * (j & 1) + 3]); pw4.z = pk_bf16(s0[8 * (j & 1) + 4], s0[8 * (j & 1) + 5]); pw4.w = pk_bf16(s0[8 * (j & 1) + 6], s0[8 * (j & 1) + 7]); }
                else       { pw4.x = pk_bf16(s1[8 * (j & 1) + 0], s1[8 * (j & 1) + 1]); pw4.y = pk_bf16(s1[8 * (j & 1) + 2], s1[8 * (j & 1) + 3]); pw4.z = pk_bf16(s1[8 * (j & 1) + 4], s1[8 * (j & 1) + 5]); pw4.w = pk_bf16(s1[8 * (j & 1) + 6], s1[8 * (j & 1) + 7]); }
                const bf16x8 pf = __builtin_bit_cast(bf16x8, pw4);
                { const u32x4 vw = {vlo[j][0].x, vlo[j][0].y, vhi[j][0].x, vhi[j][0].y}; o0 = MFMA32(__builtin_bit_cast(bf16x8, vw), pf, o0); }
                { const u32x4 vw = {vlo[j][1].x, vlo[j][1].y, vhi[j][1].x, vhi[j][1].y}; o1 = MFMA32(__builtin_bit_cast(bf16x8, vw), pf, o1); }
            }
        }
        const float inv = 1.0f / lrun;
        bf16_t* op = AS + qrow * DM + hq * 64 + 4 * hi;
#pragma unroll
        for (int g4 = 0; g4 < 4; ++g4) {
            u32x2 w0, w1;
            w0.x = pk_bf16(o0[4 * g4] * inv, o0[4 * g4 + 1] * inv); w0.y = pk_bf16(o0[4 * g4 + 2] * inv, o0[4 * g4 + 3] * inv);
            w1.x = pk_bf16(o1[4 * g4] * inv, o1[4 * g4 + 1] * inv); w1.y = pk_bf16(o1[4 * g4 + 2] * inv, o1[4 * g4 + 3] * inv);
            *(u32x2*)(op + 8 * g4) = w0; *(u32x2*)(op + 32 + 8 * g4) = w1;
        }
    }
    __syncthreads();
}

DI void scan_blk(LAS unsigned char* lds, const float* F, const float* lamT, bf16_t* ucat, int blk) {
    LAS float* E = (LAS float*)lds;
    const int tid = threadIdx.x, seg = tid >> 7, cl = tid & 127;
    {
        const int chain = blk * 128 + cl, p = chain & 63, dir = (chain >> 6) & 1, b = (chain >> 7) & 7, g = chain >> 10;
        const float ar = lamT[((g * 2 + dir) * 64 + p) * 2], ai = lamT[((g * 2 + dir) * 64 + p) * 2 + 1];
        const int comp = dir * 128 + p, rowbase = g * NROW + b * 128;
        float pr[32], pi[32]; float sr = 0.f, si = 0.f;
#pragma unroll
        for (int jj = 0; jj < 32; ++jj) {
            const int j = seg * 32 + jj, ci = dir ? 127 - j : j;
            const float fr = F[(size_t)(rowbase + ci) * 256 + comp], fi = F[(size_t)(rowbase + ci) * 256 + comp + 64];
            pr[jj] = sr; pi[jj] = si;
            const float nr = ar * sr - ai * si + fr, ni = ar * si + ai * sr + fi; sr = nr; si = ni;
        }
        __syncthreads();
        E[(seg * 128 + cl) * 2] = sr; E[(seg * 128 + cl) * 2 + 1] = si;
        __syncthreads();
        float a32r = ar, a32i = ai;
#pragma unroll
        for (int q = 0; q < 5; ++q) { const float nr = a32r * a32r - a32i * a32i, ni = 2.f * a32r * a32i; a32r = nr; a32i = ni; }
        float cr = 0.f, ci_ = 0.f;
#pragma unroll
        for (int s = 0; s < 3; ++s) if (s < seg) { const float er = E[(s * 128 + cl) * 2], ei = E[(s * 128 + cl) * 2 + 1]; const float nr = a32r * cr - a32i * ci_ + er, ni = a32r * ci_ + a32i * cr + ei; cr = nr; ci_ = ni; }
        float wr_ = 1.f, wi_ = 0.f;
#pragma unroll
        for (int jj = 0; jj < 32; ++jj) {
            const int j = seg * 32 + jj, ci = dir ? 127 - j : j;
            const float outr = pr[jj] + wr_ * cr - wi_ * ci_, outi = pi[jj] + wr_ * ci_ + wi_ * cr;
            bf16_t* d = ucat + (size_t)(rowbase + ci) * UCK + 512 + comp;
            d[0] = (bf16_t)(pk_bf16(outr, 0.f) & 0xffffu); d[64] = (bf16_t)(pk_bf16(outi, 0.f) & 0xffffu);
            const float nr = wr_ * ar - wi_ * ai, ni = wr_ * ai + wi_ * ar; wr_ = nr; wi_ = ni;
        }
    }
    __syncthreads();
}

#define XB_TMO      128
#define XB_XCNT(j)  (256  + 64 * (j))
#define XB_XSUB(j)  (1280 + 64 * (j))
#define XB_XGEN(j)  (2304 + 64 * (j))
#define XB_TOP      3328
#define XB_TOPGEN   3392
#define XCD_BAR_WORDS 3456
#define XB_SPIN_CAP (1u << 18)
DI unsigned xb_ld(unsigned* p)              { return __hip_atomic_load(p, __ATOMIC_RELAXED, __HIP_MEMORY_SCOPE_AGENT); }
DI unsigned xb_add(unsigned* p, unsigned v) { return __hip_atomic_fetch_add(p, v, __ATOMIC_RELAXED, __HIP_MEMORY_SCOPE_AGENT); }
DI unsigned xb_xcc_id() { return (unsigned)__builtin_amdgcn_s_getreg((3 << 11) | 20) & 0xFu; }
#define XB_SPIN(cond, bar) do { unsigned _sp = 0; while (cond) { __builtin_amdgcn_s_sleep(1); \
    if ((++_sp & 255u) == 0u) { if (xb_ld(&(bar)[XB_TMO])) break; if (_sp > XB_SPIN_CAP) { atomicAdd(&(bar)[XB_TMO], 1u); break; } } } } while (0)
struct XcdBarrier { unsigned* bar; unsigned x; volatile LAS unsigned* st; };
DI XcdBarrier xcd_barrier_post(unsigned* bar, volatile LAS unsigned* st) {
    XcdBarrier b; b.bar = bar; b.x = xb_xcc_id(); b.st = st;
    if (threadIdx.x == 0) (void)xb_add(&bar[XB_XCNT(b.x)], 1u);
    return b;
}
DI void xcd_barrier_complete(unsigned* bar, unsigned x, unsigned& nloc, unsigned& nx) {
    const unsigned G = gridDim.x * gridDim.y * gridDim.z;
    unsigned sum, cnt, mine, sp = 0u;
    for (;;) {
        sum = 0u; cnt = 0u; mine = 0u;
#pragma unroll
        for (unsigned j = 0; j < 16; ++j) { const unsigned c = xb_ld(&bar[XB_XCNT(j)]); sum += c; cnt += (c > 0u) ? 1u : 0u; mine = (j == x) ? c : mine; }
        if (sum == G) break;
        __builtin_amdgcn_s_sleep(1);
        if ((++sp & 255u) == 0u) { if (xb_ld(&bar[XB_TMO])) break; if (sp > XB_SPIN_CAP) { atomicAdd(&bar[XB_TMO], 1u); break; } }
    }
    nloc = mine > 0u ? mine : 1u; nx = cnt > 0u ? cnt : 1u;
}
DI void xcd_barrier(const XcdBarrier& b) {
    asm volatile("s_waitcnt vmcnt(0)" ::: "memory");
    __syncthreads();
    if (threadIdx.x == 0) {
        unsigned* bar = b.bar;
        __builtin_amdgcn_s_waitcnt(0);
        unsigned nloc = b.st[0], nx = b.st[1];
        if (nloc == 0u) { xcd_barrier_complete(bar, b.x, nloc, nx); b.st[0] = nloc; b.st[1] = nx; }
        const unsigned old = xb_add(&bar[XB_XSUB(b.x)], 1u);
        const unsigned gen = old / nloc;
        if (old + 1u == (gen + 1u) * nloc) {
            __builtin_amdgcn_fence(__ATOMIC_RELEASE, "agent");
            asm volatile("s_waitcnt vmcnt(0)" ::: "memory");
            const unsigned og = xb_add(&bar[XB_TOP], 1u);
            const unsigned tg = og / nx;
            if (og + 1u == (tg + 1u) * nx) xb_add(&bar[XB_TOPGEN], 1u);
            else XB_SPIN(xb_ld(&bar[XB_TOPGEN]) == tg, bar);
            __builtin_amdgcn_fence(__ATOMIC_ACQUIRE, "agent");
            xb_add(&bar[XB_XGEN(b.x)], 1u);
            asm volatile("s_waitcnt vmcnt(0)" ::: "memory");
        } else {
            XB_SPIN(xb_ld(&bar[XB_XGEN(b.x)]) == gen, bar);
            __builtin_amdgcn_fence(__ATOMIC_ACQUIRE, "agent");
            asm volatile("s_waitcnt vmcnt(0)" ::: "memory");
        }
    }
    __syncthreads();
}

struct Args { const float* in[21]; float* out; unsigned char* ws; int ph_lo, ph_hi, li, pad; };
constexpr int NPHASE = 11;

__global__ void __launch_bounds__(512, 2) mk_fwd(Args args) {
    extern __shared__ __attribute__((aligned(16))) unsigned char lds_raw[];
    LAS unsigned char* lds = (LAS unsigned char*)lds_raw;
    const int tid = threadIdx.x, lane = tid & 63, wid = __builtin_amdgcn_readfirstlane(tid >> 6);
    const int G = gridDim.x, bx = blockIdx.x;
    const int gw = bx * 8 + wid, NGW = G * 8;
    unsigned char* ws = args.ws;
    const float* x = args.in[0];
    bf16_t* WinT = (bf16_t*)(ws + WS_WINT); bf16_t* SWin = (bf16_t*)(ws + WS_SWIN); bf16_t* Bt2 = (bf16_t*)(ws + WS_BT2); bf16_t* WgluT = (bf16_t*)(ws + WS_WGLUT);
    bf16_t* BtCat = (bf16_t*)(ws + WS_BTCAT); bf16_t* WoT = (bf16_t*)(ws + WS_WOT); bf16_t* BtFfn = (bf16_t*)(ws + WS_BTFFN); bf16_t* WdT = (bf16_t*)(ws + WS_WDT);
    float* rope = (float*)(ws + WS_ROPE); float* lamT = (float*)(ws + WS_LAMT); float* ssq1 = (float*)(ws + WS_SSQ1); float* ssq2 = (float*)(ws + WS_SSQ2);
    bf16_t* H1 = (bf16_t*)(ws + WS_H1); bf16_t* AS = (bf16_t*)(ws + WS_AS); bf16_t* Qb = (bf16_t*)(ws + WS_Q); bf16_t* yg = (bf16_t*)(ws + WS_YG);
    bf16_t* Kb = (bf16_t*)(ws + WS_K); bf16_t* Vb = (bf16_t*)(ws + WS_V); bf16_t* ucat = (bf16_t*)(ws + WS_UCAT); bf16_t* Mg = (bf16_t*)(ws + WS_MG);
    float* Fst = (float*)(ws + WS_F); bf16_t* Ga = (bf16_t*)(ws + WS_GA); bf16_t* Gs = (bf16_t*)(ws + WS_GS); bf16_t* Xb = (bf16_t*)(ws + WS_XB); bf16_t* Hmid = (bf16_t*)(ws + WS_HMID);
    float* out = args.out; bf16_t* X2b = (bf16_t*)(ws + WS_GA);
    const int lo = args.ph_lo, hi = args.ph_hi;
    if (lo < 0) cg::this_grid().sync();
    volatile LAS unsigned* xst = (volatile LAS unsigned*)(lds + 131072);
    if (tid == 0) { xst[0] = 0u; xst[1] = 0u; xst[2] = 0u; xst[3] = 0u; }
    __syncthreads();
    const XcdBarrier xbar = xcd_barrier_post((unsigned*)(ws + WS_BAR) + args.li * XCD_BAR_WORDS, xst);
#ifndef PHASE_MASK
#define PHASE_MASK 0x7ff
#endif
#define IN(k) (((PHASE_MASK >> (k)) & 1) && lo <= (k) && (k) < hi)
#if MK_PER_PHASE
#define SEAM(k) do { } while (0)
#else
#define SEAM(k) do { if (IN(k) && IN((k) + 1)) xcd_barrier(xbar); } while (0)
#endif

#define DEFERRED_TRANSPOSES(it0, it1) do { if (bx >= 128) { LAS float* scr = (LAS float*)(lds + wid * 8448); \
        constexpr int I_GLU = 8 * 16, I_AB = 8 * 32, I_SB = 8 * 32, I_O = 16 * 32, I_G = 16 * 88, I_U = 16 * 88; \
        for (int it = (it0) + (bx - 128) * 8 + wid; it < (it1); it += (G - 128) * 8) { int r = it; \
            if (r < I_GLU) { tr_item(args.in[12], 512, 512, WgluT, 512, 0, 0, nullptr, scr, r, lane); continue; } r -= I_GLU; \
            if (r < I_AB) { tr_item(args.in[13], 512, DM, BtCat, DM, 0, 0, nullptr, scr, r, lane); continue; } r -= I_AB; \
            if (r < I_SB) { tr_item(args.in[14], 512, DM, BtCat, DM, 512, 0, nullptr, scr, r, lane); continue; } r -= I_SB; \
            if (r < I_O) { tr_item(args.in[15], DM, DM, WoT, DM, 0, 0, nullptr, scr, r, lane); continue; } r -= I_O; \
            if (r < I_G) { tr_item(args.in[17], DM, DFF, BtFfn, DM, 0, 1, args.in[16], scr, r, lane); continue; } r -= I_G; \
            if (r < I_U) { tr_item(args.in[18], DM, DFF, BtFfn, DM, 0, 2, args.in[16], scr, r, lane); continue; } r -= I_U; \
            tr_item(args.in[19], DFF, DM, WdT, DFF, 0, 0, nullptr, scr, r, lane); } \
        __syncthreads(); } } while (0)
    constexpr int N_DEFERRED = 8 * 16 + 8 * 32 + 8 * 32 + 16 * 32 + 16 * 88 + 16 * 88 + 44 * 32, N_DEF_P1 = N_DEFERRED;

    if (IN(0)) {
        if (bx < 64) ssm_tables(lds, bx >> 1, bx & 1, args.in[4], args.in[5], args.in[6], args.in[7], args.in[8], args.in[9], args.in[10], args.in[11], SWin, Bt2, lamT);
        else if (bx < 128) {
            const int i = (bx - 64) * 512 + tid;
            const int pos = i >> 3, j = i & 7; const float inv = powf(500000.0f, -(float)j / 8.0f); float sn, cs; sincosf((float)pos * inv, &sn, &cs);
            rope[pos * 16 + j] = cs; rope[pos * 16 + 8 + j] = sn;
        }
        {
            LAS float* scr = (LAS float*)(lds + wid * 8448);
            constexpr int NTR = 16 * 104, NITEMS = NTR + NTOK / 4;
            const float* g1 = args.in[1];
            f32x4 g1v[4];
#pragma unroll
            for (int j = 0; j < 4; ++j) g1v[j] = *((const f32x4*)g1 + lane + 64 * j);
            const int nslot = (G - 64) * 16 + 512;
            const int s0_ = bx >= 64 ? ((bx - 64) * 8 + wid) * 2 : (G - 64) * 16 + bx * 8 + wid, ns_ = bx >= 64 ? 2 : 1;
            for (int itb = 0; itb < NITEMS; itb += nslot)
            for (int sub = 0; sub < ns_; ++sub) {
                const int it = itb + s0_ + sub; if (it >= NITEMS) break;
                int r = it;
                if (r >= NTR) {
                    const int m0 = (r - NTR) * 4;
                    f32x4 v[4][4]; float ssv[4];
#pragma unroll
                    for (int q = 0; q < 4; ++q) { const f32x4* xr = (const f32x4*)(x + (size_t)(m0 + q) * DM) + lane;
#pragma unroll
                        for (int j = 0; j < 4; ++j) v[q][j] = __builtin_nontemporal_load(xr + 64 * j); }
#pragma unroll
                    for (int q = 0; q < 4; ++q) { float s_ = 0.f;
#pragma unroll
                        for (int j = 0; j < 4; ++j) s_ += (v[q][j][0] * v[q][j][0] + v[q][j][1] * v[q][j][1]) + (v[q][j][2] * v[q][j][2] + v[q][j][3] * v[q][j][3]);
                        ssv[q] = 1.0f / sqrtf(wave_sum(s_) * (1.0f / DM) + RMS_EPS); }
#pragma unroll
                    for (int j = 0; j < 4; ++j) { const f32x4 gv = g1v[j];
#pragma unroll
                        for (int q = 0; q < 4; ++q) { const f32x4 w = v[q][j] * ssv[q] * gv; u32x2 o; o.x = pk_bf16(w[0], w[1]); o.y = pk_bf16(w[2], w[3]); *((u32x2*)(H1 + (size_t)(m0 + q) * DM) + lane + 64 * j) = o; } }
                    continue;
                }
                tr_item(args.in[2], DM, INC, WinT, DM, 0, 3, nullptr, scr, r, lane);
            }
        }
        __syncthreads();
    }
    SEAM(0);
    if (IN(1)) {
        pg8::Gemm g{H1, WinT, DM, DM, DM, 16, 0, 0}; pg8::StaticOrder S; S.init(NTOK / 256, INC / 256, G, bx);
        EpiIn E{Qb, Kb, Vb, ucat, Ga, Gs, rope};
        pg8::gemm_phase(lds, g, S, E);
        DEFERRED_TRANSPOSES(0, N_DEF_P1);
    }
    SEAM(1);
    if (IN(2)) {
        {
            pg8::Gemm g{ucat, SWin, UCK, 512, 512, 16, 0, 0}; pg8::GroupOrder S; S.init(32, 4, 1, G, bx); EpiF E{Fst}; pg8::gemm_phase(lds, g, S, E);
            for (int i = 0; ; ++i) { Unit u; if (!S.next(i, u)) break;
                asm volatile("s_waitcnt vmcnt(0)" ::: "memory"); __syncthreads();
                scan_blk(lds, Fst, lamT, ucat, u.pm * 2); scan_blk(lds, Fst, lamT, ucat, u.pm * 2 + 1); }
        }
        DEFERRED_TRANSPOSES(N_DEF_P1, N_DEFERRED);
        {
            int u0, u1;
            if (G == 256) { if (bx < 128) { u0 = bx * 3; u1 = u0 + 3; } else { u0 = 384 + (bx - 128) * 5; u1 = u0 + 5; } }
            else { const int per = (1024 + G - 1) / G; u0 = bx * per; u1 = u0 + per < 1024 ? u0 + per : 1024; if (u0 > 1024) u0 = 1024; }
            attn_phase(lds, Qb, Kb, Vb, AS, args.in[3], u0, u1);
        }
    }
    SEAM(2);
    if (IN(4)) { pg8::Gemm g{ucat, Bt2, UCK, UCK, UCK, 16, 0, 0}; pg8::GroupOrder S; S.init(32, 4, 2, G, bx); EpiY E{yg}; pg8::gemm_phase(lds, g, S, E); }
    SEAM(4);
    if (IN(5)) { pg8::Gemm g{yg, WgluT, 16, 512, 512, NTOK * 16, 0, 0}; pg8::StaticOrder S; S.init(NTOK / 256, 2, G, bx); EpiGlu E{yg, AS}; pg8::gemm_phase(lds, g, S, E); }
    SEAM(5);
    if (IN(6)) { pg8::Gemm g{AS, BtCat, DM, DM, 512, 16, 1024, 1024}; pg8::StaticOrder S; S.init(NTOK / 256, 4, G, bx, 1); EpiMerge E{Ga, Gs, Mg}; pg8::gemm_phase(lds, g, S, E); }
    SEAM(6);
    if (IN(7)) { pg8::Gemm g{Mg, WoT, DM, DM, DM, 16, 0, 0}; pg8::StaticOrder S; S.init(NTOK / 256, 4, G, bx); EpiRes<false> E{x, nullptr, Xb, ssq1}; pg8::gemm_phase(lds, g, S, E); }
    SEAM(7);
    if (IN(8)) { pg8::Gemm g{Xb, BtFfn, DM, DM, DM, 16, 0, 0}; pg8::StaticOrder S; S.init(NTOK / 256, 2 * DFF / 256, G, bx); EpiFfn1 E{ssq1, Hmid}; pg8::gemm_phase(lds, g, S, E); }
    SEAM(8);
    if (IN(9)) { pg8::Gemm g{Hmid, WdT, DFF, DFF, DFF, 16, 0, 0}; pg8::StaticOrder S; S.init(NTOK / 256, 4, G, bx); EpiRes<true> E{nullptr, Xb, X2b, ssq2}; pg8::gemm_phase(lds, g, S, E); }
    SEAM(9);
#ifdef MK_EXTRA_SYNCS
    if (IN(9)) for (int e = 0; e < MK_EXTRA_SYNCS; ++e) xcd_barrier(xbar);
#endif
    if (IN(10)) {
        const float* gf = args.in[20];
        f32x4 gv[4];
#pragma unroll
        for (int j = 0; j < 4; ++j) gv[j] = *((const f32x4*)gf + lane + 64 * j);
        for (int m0 = gw * 4; m0 < NTOK; m0 += NGW * 4) {
            u32x2 w[4][4]; float rsv[4];
#pragma unroll
            for (int q = 0; q < 4; ++q) {
                const u32x2* xr = (const u32x2*)(X2b + (size_t)(m0 + q) * DM) + lane;
#pragma unroll
                for (int j = 0; j < 4; ++j) w[q][j] = __builtin_nontemporal_load(xr + 64 * j);
                rsv[q] = ssq2[(size_t)(m0 + q) * 16 + (lane & 15)];
            }
#pragma unroll
            for (int q = 0; q < 4; ++q) {
                float tot = rsv[q]; tot += __shfl_xor(tot, 1); tot += __shfl_xor(tot, 2); tot += __shfl_xor(tot, 4); tot += __shfl_xor(tot, 8);
                const float rs = 1.0f / sqrtf(tot * (1.0f / DM) + RMS_EPS);
                f32x4* orow = (f32x4*)(out + (size_t)(m0 + q) * DM) + lane;
#pragma unroll
                for (int j = 0; j < 4; ++j) { f32x4 v; v[0] = bf_lo(w[q][j].x); v[1] = bf_hi(w[q][j].x); v[2] = bf_lo(w[q][j].y); v[3] = bf_hi(w[q][j].y); __builtin_nontemporal_store(v * rs * gv[j], orow + 64 * j); }
            }
        }
    }
}

extern "C" void kernel_launch(void* const* d_in, const int* in_sizes, int n_in, void* d_out, int out_size, void* d_ws, size_t ws_size, hipStream_t stream) {
    static int grid = 0;
    if (grid == 0) {
        if (n_in != 21 || in_sizes[0] != NTOK * DM || out_size != NTOK * DM || ws_size < WS_END) {
            fprintf(stderr, "kernel_launch: unexpected shapes (n_in %d, in0 %d, out %d, ws %zu); nothing launched\n", n_in, n_in > 0 ? in_sizes[0] : -1, out_size, ws_size); grid = -1; return; }
        int dev = 0, cus = 0, per_cu = 0;
        hipGetDevice(&dev); hipDeviceGetAttribute(&cus, hipDeviceAttributeMultiprocessorCount, dev);
        if (hipFuncSetAttribute((const void*)mk_fwd, hipFuncAttributeMaxDynamicSharedMemorySize, LDS_BYTES) != hipSuccess) { fprintf(stderr, "kernel_launch: hipFuncSetAttribute failed\n"); grid = -1; return; }
        if (hipOccupancyMaxActiveBlocksPerMultiprocessor(&per_cu, (const void*)mk_fwd, 512, LDS_BYTES) != hipSuccess || per_cu < 1) { fprintf(stderr, "kernel_launch: occupancy query says %d\n", per_cu); per_cu = 1; }
        (void)hipGetLastError();
        grid = cus * 1;
    }
    if (grid < 0) return;
    Args a{};
    for (int i = 0; i < 21; ++i) a.in[i] = (const float*)d_in[i];
    a.out = (float*)d_out; a.ws = (unsigned char*)d_ws;
    static const int ranges[][2] = {MK_RANGES};
    static_assert(sizeof(ranges) / sizeof(ranges[0]) <= 4, "one barrier-word region per launch");
    if (hipMemsetAsync((char*)d_ws + WS_BAR, 0, 4 * XCD_BAR_WORDS * 4 + 1024, stream) != hipSuccess) { fprintf(stderr, "kernel_launch: hipMemsetAsync failed\n"); return; }
    for (unsigned li = 0; li < sizeof(ranges) / sizeof(ranges[0]); ++li) {
        a.ph_lo = ranges[li][0]; a.ph_hi = ranges[li][1]; a.li = (int)li;
        void* kargs[] = {&a};
        hipError_t e = hipLaunchCooperativeKernel((const void*)mk_fwd, dim3(grid), dim3(512), kargs, LDS_BYTES, stream);
        if (e != hipSuccess) fprintf(stderr, "kernel_launch: cooperative launch failed: %s (grid %d)\n", hipGetErrorString(e), grid);
    }
}
```

```cpp
#include <hip/hip_runtime.h>
#include <hip/hip_cooperative_groups.h>
#include <cstdio>
#include <cstdint>
namespace cg = cooperative_groups;

#ifndef MK_RANGES
#define MK_RANGES {0, 11}
#endif
#ifndef MK_PER_PHASE
#define MK_PER_PHASE 0
#endif

#define LAS __attribute__((address_space(3)))
typedef unsigned short bf16_t;
typedef short bf16x8 __attribute__((ext_vector_type(8)));
typedef float f32x4 __attribute__((ext_vector_type(4)));
typedef float f32x2 __attribute__((ext_vector_type(2)));
typedef float f32x16 __attribute__((ext_vector_type(16)));
typedef unsigned u32x4 __attribute__((ext_vector_type(4)));
typedef unsigned u32x2 __attribute__((ext_vector_type(2)));
typedef __bf16 bf2_t __attribute__((ext_vector_type(2)));
#define DI __device__ __forceinline__

constexpr int NTOK = 32768, DM = 1024, SEQ = 4096, INC = 3328, DFF = 2816;
constexpr int CH = 32;
constexpr int NROW = NTOK / CH;
constexpr int UCK = 768;
constexpr float RMS_EPS = 1e-6f;

constexpr size_t MiB = 1u << 20;
constexpr size_t WS_WINT = 0;
constexpr size_t WS_SWIN = WS_WINT + (size_t)INC * DM * 2;
constexpr size_t WS_BT2 = WS_SWIN + (size_t)32 * 256 * 512 * 2;
constexpr size_t WS_WGLUT = WS_BT2 + (size_t)32 * 512 * 768 * 2;
constexpr size_t WS_BTCAT = WS_WGLUT + (size_t)512 * 512 * 2;
constexpr size_t WS_WOT = WS_BTCAT + (size_t)DM * DM * 2;
constexpr size_t WS_BTFFN = WS_WOT + (size_t)DM * DM * 2;
constexpr size_t WS_WDT = WS_BTFFN + (size_t)2 * DFF * DM * 2;
constexpr size_t WS_ROPE = WS_WDT + (size_t)DM * DFF * 2;
constexpr size_t WS_LAMT = WS_ROPE + (size_t)SEQ * 16 * 4;
constexpr size_t WS_SSQ1 = WS_LAMT + (size_t)32 * 2 * 64 * 2 * 4;
constexpr size_t WS_SSQ2 = WS_SSQ1 + (size_t)NTOK * 16 * 4;
constexpr size_t WS_BAR = WS_SSQ2 + (size_t)NTOK * 16 * 4;
constexpr size_t WS_WEND = WS_BAR + 4 * 3456 * 4 + 1024;
static_assert(WS_WEND <= 72 * MiB, "weights region");
constexpr size_t WS_H1 = 72 * MiB;
constexpr size_t WS_AS = WS_H1;
constexpr size_t WS_Q = 136 * MiB;
constexpr size_t WS_YG = WS_Q;
constexpr size_t WS_K = 168 * MiB;
constexpr size_t WS_V = 176 * MiB;
constexpr size_t WS_UCAT = 184 * MiB;
constexpr size_t WS_MG = WS_UCAT;
constexpr size_t WS_F = 232 * MiB;
constexpr size_t WS_GA = 264 * MiB;
constexpr size_t WS_GS = 328 * MiB;
constexpr size_t WS_XB = 392 * MiB;
constexpr size_t WS_HMID = 72 * MiB;
constexpr size_t WS_END = 456 * MiB;
static_assert(WS_HMID + (size_t)NTOK * DFF * 2 <= WS_GA, "hmid overlay");

constexpr int LDS_BYTES = 147456;

DI unsigned pk_bf16(float lo, float hi) { f32x2 v = {lo, hi}; bf2_t b = __builtin_convertvector(v, bf2_t); return __builtin_bit_cast(unsigned, b); }
DI float bf_lo(unsigned u) { return __uint_as_float(u << 16); }
DI float bf_hi(unsigned u) { return __uint_as_float(u & 0xffff0000u); }
DI u32x4 pack8(const f32x4& a, const f32x4& b) { u32x4 w; w.x = pk_bf16(a[0], a[1]); w.y = pk_bf16(a[2], a[3]); w.z = pk_bf16(b[0], b[1]); w.w = pk_bf16(b[2], b[3]); return w; }
DI void unpack8(const u32x4& w, f32x4& a, f32x4& b) { a[0] = bf_lo(w.x); a[1] = bf_hi(w.x); a[2] = bf_lo(w.y); a[3] = bf_hi(w.y); b[0] = bf_lo(w.z); b[1] = bf_hi(w.z); b[2] = bf_lo(w.w); b[3] = bf_hi(w.w); }
DI float xhalf_sum(float x) { const unsigned u = __float_as_uint(x); const auto r = __builtin_amdgcn_permlane32_swap(u, u, false, false); return __uint_as_float(r[0]) + __uint_as_float(r[1]); }
DI float xhalf_max(float x) { const unsigned u = __float_as_uint(x); const auto r = __builtin_amdgcn_permlane32_swap(u, u, false, false); return fmaxf(__uint_as_float(r[0]), __uint_as_float(r[1])); }
DI float sigmoid_f(float x) { return __builtin_amdgcn_rcpf(1.0f + __expf(-x)); }
DI float gelu_tanh(float x) { const float t = 1.5957691216f * (x + 0.044715f * x * x * x); return x * sigmoid_f(t); }
DI float wave_sum(float v) {
#pragma unroll
    for (int o = 1; o < 64; o <<= 1) v += __shfl_xor(v, o);
    return v;
}

namespace pg8 {
constexpr int BM = 256, BK = 64, HALF = 128, HTB = HALF * BK * 2, NXCD = 8, WGM = 8;
DI int lds_byte(int r, int c) { const int st = (r >> 4) * 2 + (c >> 5), rr = r & 15, cc = c & 31, ob = rr * 64 + cc * 2; return st * 1024 + (ob ^ (((ob >> 9) & 1) << 5)); }
DI void stage_rc(int b, int& R, int& C) { const int st = b / 1024, sb = b % 1024, swz = sb ^ (((sb >> 9) & 1) << 5); R = (st >> 1) * 16 + swz / 64; C = (st & 1) * 32 + (swz % 64) / 2; }
DI int perm32(int rho) { const int n = rho >> 4, i = rho & 15; return 8 * (i >> 2) + 4 * n + (i & 3); }

struct Unit { int pm, pn, kh; };
struct Gemm { const bf16_t* A; const bf16_t* Bt; int lda, ldb, K, ksubA; int kofsA, kofsB; };

DI int xcd_remap(int wgid, int nwg) { const int q = nwg / NXCD, r = nwg % NXCD, xcd = wgid % NXCD, off = wgid / NXCD; return (xcd < r ? xcd * (q + 1) : r * (q + 1) + (xcd - r) * q) + off; }
struct StaticOrder {
    int nM, nN, nwg, G, c, pair;
    DI void init(int nM_, int nN_, int G_, int c_, int pair_ = 0) { nM = nM_; nN = nN_; nwg = nM * nN; G = G_; c = c_; pair = pair_; }
    DI bool next(int i, Unit& u) const {
        const long L = (long)(pair ? (i >> 1) : i) * G + c; if (L >= nwg) return false;
        u.kh = pair ? (i & 1) : 0;
        const int wgid = xcd_remap((int)L, nwg);
        const int nig = WGM * nN, gid = wgid / nig, fm = gid * WGM, gsz = (nM - fm) < WGM ? (nM - fm) : WGM;
        u.pm = fm + ((wgid % nig) % gsz); u.pn = (wgid % nig) / gsz; return true;
    }
};
struct GroupOrder {
    int gm, gn, nwg, G, c;
    DI void init(int ngrp, int gm_, int gn_, int G_, int c_) { gm = gm_; gn = gn_; nwg = ngrp * gm * gn; G = G_; c = c_; }
    DI bool next(int i, Unit& u) const {
        const long L = (long)i * G + c; if (L >= nwg) return false;
        u.kh = 0;
        const int wgid = xcd_remap((int)L, nwg);
        const int per = gm * gn, g = wgid / per, r = wgid % per;
        u.pm = g * gm + (r % gm); u.pn = g * gn + (r / gm); return true;
    }
};

typedef f32x4 Acc[2][2][4][2];

template <class Epi, class Sched>
DI void gemm_phase(LAS unsigned char* lds, const Gemm g, const Sched& S, const Epi& E) {
    const int tid = threadIdx.x, wid = __builtin_amdgcn_readfirstlane(tid >> 6), lane = tid & 63, wr = wid >> 2, wc = wid & 3, fr = lane & 15, fq = lane >> 4;
    const int K = g.K, nt = K / BK;
    unsigned voffA[2], voffB[2];
#pragma unroll
    for (int i = 0; i < 2; ++i) { int R, C; stage_rc(tid * 16 + i * 8192, R, C); const int Rb = (R & ~31) + perm32(R & 31);
        voffA[i] = (unsigned)(R * g.lda + (C >> 4) * g.ksubA + (C & 15)) * 2u; voffB[i] = (unsigned)(Rb * g.ldb + C) * 2u; }
    const size_t kstepA = (size_t)g.ksubA * 8, kstepB = (size_t)(BK * 2);
    const size_t hstepA = (size_t)HALF * g.lda * 2, hstepB = (size_t)HALF * g.ldb * 2;
    const size_t tstepA = 2 * hstepA, tstepB = 2 * hstepB;
    const unsigned ldsw = (unsigned)wid * 1024u;
    const int aoff = lds_byte(wr * 64 + fr, fq * 8), boff = lds_byte(wc * 32 + fr, fq * 8);
#define PG8_SA(b, h) (((b) * 2 + (h)) * HTB)
#define PG8_SB(b, h) ((4 + (b) * 2 + (h)) * HTB)
#define PG8_STAGE(bufoff, gbase, voff) do { _Pragma("unroll") for (int _i = 0; _i < 2; ++_i) \
        __builtin_amdgcn_global_load_lds((const unsigned*)((const char*)(gbase) + (voff)[_i]), (LAS unsigned*)(lds + (bufoff) + ldsw + _i * 8192), 16, 0, 0); } while (0)
#define PG8_LDA(dst, b, h) do { _Pragma("unroll") for (int m = 0; m < 4; ++m) _Pragma("unroll") for (int k = 0; k < 2; ++k) dst[m][k] = *(const LAS bf16x8*)(lds + PG8_SA(b, h) + aoff + m * 2048 + k * 1024); } while (0)
#define PG8_LDB(dst, b, h) do { _Pragma("unroll") for (int n = 0; n < 2; ++n) _Pragma("unroll") for (int k = 0; k < 2; ++k) dst[n][k] = *(const LAS bf16x8*)(lds + PG8_SB(b, h) + boff + n * 2048 + k * 1024); } while (0)
#define PG8_MMA(ai, bj, At, Bt) do { __builtin_amdgcn_s_setprio(1); _Pragma("unroll") for (int m = 0; m < 4; ++m) _Pragma("unroll") for (int n = 0; n < 2; ++n) _Pragma("unroll") for (int k = 0; k < 2; ++k) \
        acc[ai][bj][m][n] = __builtin_amdgcn_mfma_f32_16x16x32_bf16(Bt[n][k], At[m][k], acc[ai][bj][m][n], 0, 0, 0); __builtin_amdgcn_s_setprio(0); } while (0)
#define PG8_WAIT_V(n) asm volatile("s_waitcnt vmcnt(" #n ")" ::: "memory")
#define PG8_WAIT_L(n) asm volatile("s_waitcnt lgkmcnt(" #n ")" ::: "memory")
#define PG8_BAR __builtin_amdgcn_s_barrier()
#define PG8_SCHED __builtin_amdgcn_sched_barrier(0)
    Unit cur, nxt; int ui = 0;
    if (!S.next(0, cur)) return;
    Acc acc;
#pragma unroll
    for (int a = 0; a < 2; ++a)
#pragma unroll
        for (int b = 0; b < 2; ++b)
#pragma unroll
            for (int m = 0; m < 4; ++m)
#pragma unroll
                for (int n = 0; n < 2; ++n) acc[a][b][m][n] = (f32x4){0.f, 0.f, 0.f, 0.f};
    bf16x8 At[4][2], B0[2][2], B1[2][2];
    const char* cA = (const char*)g.A + (size_t)cur.pm * tstepA + (size_t)cur.kh * g.kofsA; const char* cB = (const char*)g.Bt + (size_t)cur.pn * tstepB + (size_t)cur.kh * g.kofsB;
    PG8_STAGE(PG8_SB(0, 0), cB, voffB); PG8_STAGE(PG8_SB(0, 1), cB + hstepB, voffB); PG8_STAGE(PG8_SA(0, 0), cA, voffA); PG8_STAGE(PG8_SA(0, 1), cA + hstepA, voffA);
    if (wr == 1) PG8_BAR;
    PG8_WAIT_V(2); PG8_BAR;
    PG8_STAGE(PG8_SB(1, 0), cB + kstepB, voffB); PG8_STAGE(PG8_SA(1, 0), cA + kstepA, voffA); PG8_STAGE(PG8_SB(1, 1), cB + hstepB + kstepB, voffB);
    PG8_WAIT_V(6); PG8_BAR;
    for (;;) {
        const bool has_next = S.next(ui + 1, nxt);
        const char* nA = has_next ? (const char*)g.A + (size_t)nxt.pm * tstepA + (size_t)nxt.kh * g.kofsA : cA; const char* nB = has_next ? (const char*)g.Bt + (size_t)nxt.pn * tstepB + (size_t)nxt.kh * g.kofsB : cB;
        for (int t = 0; t < nt; t += 2) {
            const bool last = (t == nt - 2);
            const char* a1 = cA + (size_t)(t + 1) * kstepA;
            const char* a2 = last ? nA : cA + (size_t)(t + 2) * kstepA; const char* b2 = last ? nB : cB + (size_t)(t + 2) * kstepB;
            const char* a3 = a2 + kstepA; const char* b3 = b2 + kstepB;
            PG8_LDB(B0, 0, 0); PG8_LDB(B1, 0, 1); PG8_SCHED; PG8_LDA(At, 0, 0); PG8_STAGE(PG8_SA(1, 1), a1 + hstepA, voffA);
            PG8_WAIT_V(8); PG8_WAIT_L(0); PG8_BAR; PG8_MMA(0, 0, At, B0); PG8_MMA(0, 1, At, B1); PG8_BAR; PG8_SCHED;
            PG8_LDA(At, 0, 1); PG8_STAGE(PG8_SB(0, 0), b2, voffB); PG8_STAGE(PG8_SB(0, 1), b2 + hstepB, voffB); PG8_STAGE(PG8_SA(0, 0), a2, voffA);
            PG8_WAIT_V(8); PG8_WAIT_L(0); PG8_BAR; PG8_MMA(1, 0, At, B0); PG8_MMA(1, 1, At, B1); PG8_BAR; PG8_SCHED;
            PG8_LDB(B0, 1, 0); PG8_LDB(B1, 1, 1); PG8_SCHED; PG8_LDA(At, 1, 0); PG8_STAGE(PG8_SA(0, 1), a2 + hstepA, voffA);
            PG8_WAIT_V(8); PG8_WAIT_L(0); PG8_BAR; PG8_MMA(0, 0, At, B0); PG8_MMA(0, 1, At, B1); PG8_BAR; PG8_SCHED;
            PG8_LDA(At, 1, 1); PG8_STAGE(PG8_SB(1, 0), b3, voffB); PG8_STAGE(PG8_SB(1, 1), b3 + hstepB, voffB); PG8_STAGE(PG8_SA(1, 0), a3, voffA);
            PG8_WAIT_V(8); PG8_WAIT_L(0); PG8_BAR; PG8_MMA(1, 0, At, B0); PG8_MMA(1, 1, At, B1); PG8_BAR; PG8_SCHED;
        }
        if (wr == 0) PG8_BAR;
        E(acc, cur, wr, wc, fr, fq);
        if (!has_next) break;
        if (!(Epi::MID > 0 && cur.kh == 0))
#pragma unroll
        for (int a = 0; a < 2; ++a)
#pragma unroll
            for (int b = 0; b < 2; ++b)
#pragma unroll
                for (int m = 0; m < 4; ++m)
#pragma unroll
                    for (int n = 0; n < 2; ++n) acc[a][b][m][n] = (f32x4){0.f, 0.f, 0.f, 0.f};
        cur = nxt; cA = nA; cB = nB; ++ui;
        if (wr == 1) PG8_BAR;
    }
    PG8_WAIT_V(0);
    PG8_BAR;
#undef PG8_SA
#undef PG8_SB
#undef PG8_STAGE
#undef PG8_LDA
#undef PG8_LDB
#undef PG8_MMA
#undef PG8_WAIT_V
#undef PG8_WAIT_L
#undef PG8_BAR
#undef PG8_SCHED
}
}
using pg8::Acc; using pg8::Unit;

struct EpiIn {
    static constexpr int MID = 0;
    bf16_t *Q, *Kb, *Vb, *ucat, *Ga, *Gs; const float* rope;
    DI void operator()(Acc& acc, const Unit& u, int wr, int wc, int fr, int fq) const {
        const int pn = u.pn, row0 = u.pm * 256 + wr * 64 + fr;
#pragma unroll
        for (int ai = 0; ai < 2; ++ai) {
            f32x4 rc[4][4];
            if (pn < 3 && (wc & 1) == 0 && fq < 2) {
#pragma unroll
                for (int m = 0; m < 4; ++m) { const float* cs = rope + (size_t)((row0 + ai * 128 + m * 16) & (SEQ - 1)) * 16;
                    rc[m][0] = *(const f32x4*)cs; rc[m][1] = *(const f32x4*)(cs + 4); rc[m][2] = *(const f32x4*)(cs + 8); rc[m][3] = *(const f32x4*)(cs + 12); }
            } else {
#pragma unroll
                for (int m = 0; m < 4; ++m) { rc[m][0] = rc[m][1] = rc[m][2] = rc[m][3] = (f32x4){0.f, 0.f, 0.f, 0.f}; }
            }
            __builtin_amdgcn_sched_barrier(0);
#pragma unroll
            for (int m = 0; m < 4; ++m) {
                const int row = row0 + ai * 128 + m * 16;
#pragma unroll
                for (int bj = 0; bj < 2; ++bj) {
                    f32x4 v0 = acc[ai][bj][m][0], v1 = acc[ai][bj][m][1];
                    const int col = pn * 256 + bj * 128 + wc * 32 + 8 * fq;
                    if (pn < 3) {
                        const bool is_v = (pn == 2 && bj == 1);
                        if (!is_v && (wc & 1) == 0) {
                            f32x4 p0, p1;
#pragma unroll
                            for (int j = 0; j < 4; ++j) { p0[j] = __shfl_xor(v0[j], 16); p1[j] = __shfl_xor(v1[j], 16); }
                            if (fq < 2) {
                                const f32x4 c0 = rc[m][0], c1 = rc[m][1], s0 = rc[m][2], s1 = rc[m][3];
                                const float sg = fq == 0 ? -1.f : 1.f;
                                v0 = v0 * c0 + sg * (p0 * s0); v1 = v1 * c1 + sg * (p1 * s1);
                            }
                        }
                        if (pn < 2) { v0 = v0 * 0.18033688f; v1 = v1 * 0.18033688f;     *(u32x4*)(Q + (size_t)row * 512 + col) = pack8(v0, v1); }
                        else if (bj == 0) *(u32x4*)(Kb + (size_t)row * 128 + (col - 512)) = pack8(v0, v1);
                        else *(u32x4*)(Vb + (size_t)row * 128 + (col - 640)) = pack8(v0, v1);
                    } else if (pn < 5) {
                        const int cu = col - 768, gi = cu >> 4, hh0 = cu & 15;
                        *(u32x4*)(ucat + ((size_t)gi * NROW + (row >> 5)) * UCK + (row & 31) * 16 + hh0) = pack8(v0, v1);
                    } else if (bj == 0) {
                        const f32x4 a0 = acc[ai][0][m][0], a1 = acc[ai][0][m][1], b0 = acc[ai][1][m][0], b1 = acc[ai][1][m][1];
                        f32x4 r0, r1, g0, g1;
#pragma unroll
                        for (int j = 0; j < 4; ++j) {
                            const float pa0 = 1.0f + __expf(-a0[j]), pa1 = 1.0f + __expf(-a1[j]), pb0 = 1.0f + __expf(-b0[j]), pb1 = 1.0f + __expf(-b1[j]);
                            const float i0 = __builtin_amdgcn_rcpf(pa0 * pb0), i1 = __builtin_amdgcn_rcpf(pa1 * pb1);
                            g0[j] = pa0 * i0; g1[j] = pa1 * i1;
                            r0[j] = pb0 * pb0 * i0; r1[j] = pb1 * pb1 * i1;
                        }
                        const size_t o = (size_t)row * DM + (pn - 5) * 128 + wc * 32 + 8 * fq;
                        *(u32x4*)(Ga + o) = pack8(r0, r1); *(u32x4*)(Gs + o) = pack8(g0, g1);
                    }
                }
            }
        }
    }
};
struct EpiF {
    static constexpr int MID = 0;
    float* F;
    DI void operator()(Acc& acc, const Unit& u, int wr, int wc, int fr, int fq) const {
        const int row0 = u.pm * 256 + wr * 64 + fr;
#pragma unroll
        for (int ai = 0; ai < 2; ++ai)
#pragma unroll
            for (int m = 0; m < 4; ++m)
#pragma unroll
                for (int bj = 0; bj < 2; ++bj) {
                    float* p = F + (size_t)(row0 + ai * 128 + m * 16) * 256 + bj * 128 + wc * 32 + 8 * fq;
                    *(f32x4*)p = acc[ai][bj][m][0]; *(f32x4*)(p + 4) = acc[ai][bj][m][1];
                }
    }
};
struct EpiY {
    static constexpr int MID = 0;
    bf16_t* yg;
    DI void operator()(Acc& acc, const Unit& u, int wr, int wc, int fr, int fq) const {
        const int row0 = u.pm * 256 + wr * 64 + fr, colt = (u.pn & 1) * 256 + wc * 32 + 8 * fq;
#pragma unroll
        for (int ai = 0; ai < 2; ++ai)
#pragma unroll
            for (int m = 0; m < 4; ++m)
#pragma unroll
                for (int bj = 0; bj < 2; ++bj) {
                    f32x4 v0 = acc[ai][bj][m][0], v1 = acc[ai][bj][m][1];
#pragma unroll
                    for (int j = 0; j < 4; ++j) { v0[j] = gelu_tanh(v0[j]); v1[j] = gelu_tanh(v1[j]); }
                    *(u32x4*)(yg + (size_t)(row0 + ai * 128 + m * 16) * 512 + colt + bj * 128) = pack8(v0, v1);
                }
    }
};
struct EpiGlu {
    static constexpr int MID = 0;
    const bf16_t* yg; bf16_t* AS;
    DI void operator()(Acc& acc, const Unit& u, int wr, int wc, int fr, int fq) const {
        const int row0 = u.pm * 256 + wr * 64 + fr;
        u32x4 yv[2][4][2];
#pragma unroll
        for (int ai = 0; ai < 2; ++ai)
#pragma unroll
            for (int m = 0; m < 4; ++m)
#pragma unroll
                for (int bj = 0; bj < 2; ++bj) { const int col = u.pn * 256 + bj * 128 + wc * 32 + 8 * fq;
                    yv[ai][m][bj] = *(const u32x4*)(yg + (size_t)(col >> 4) * (NTOK * 16) + (size_t)(row0 + ai * 128 + m * 16) * 16 + (col & 15)); }
        __builtin_amdgcn_sched_barrier(0);
#pragma unroll
        for (int ai = 0; ai < 2; ++ai)
#pragma unroll
            for (int m = 0; m < 4; ++m) {
                const int row = row0 + ai * 128 + m * 16;
#pragma unroll
                for (int bj = 0; bj < 2; ++bj) {
                    const int col = u.pn * 256 + bj * 128 + wc * 32 + 8 * fq;
                    const u32x4 yw = yv[ai][m][bj];
                    f32x4 y0, y1; unpack8(yw, y0, y1);
                    f32x4 v0 = acc[ai][bj][m][0], v1 = acc[ai][bj][m][1];
#pragma unroll
                    for (int j = 0; j < 4; ++j) { v0[j] = y0[j] * sigmoid_f(v0[j]); v1[j] = y1[j] * sigmoid_f(v1[j]); }
                    *(u32x4*)(AS + (size_t)row * DM + 512 + col) = pack8(v0, v1);
                }
            }
    }
};
struct EpiMerge {
    static constexpr int MID = 8;
    const bf16_t *Ga, *Gs; bf16_t* Mg;
    DI void mid(Acc& acc, const Unit& u, int wr, int wc, int fr, int fq) const {
        const char* base = (const char*)Ga + ((size_t)u.pm * 256 * DM + (size_t)u.pn * 256) * 2;
        const unsigned lo = (unsigned)((wr * 64 + fr) * DM + wc * 32 + 8 * fq) * 2u;
        u32x4 w[2][4][2];
#pragma unroll
        for (int ai = 0; ai < 2; ++ai)
#pragma unroll
            for (int m = 0; m < 4; ++m)
#pragma unroll
                for (int bj = 0; bj < 2; ++bj) w[ai][m][bj] = *(const u32x4*)(base + (size_t)((ai * 128 + m * 16) * DM + bj * 128) * 2 + lo);
        __builtin_amdgcn_sched_barrier(0);
#pragma unroll
        for (int ai = 0; ai < 2; ++ai)
#pragma unroll
            for (int m = 0; m < 4; ++m)
#pragma unroll
                for (int bj = 0; bj < 2; ++bj) { f32x4 a0, a1; unpack8(w[ai][m][bj], a0, a1); acc[ai][bj][m][0] *= a0; acc[ai][bj][m][1] *= a1; }
    }
    DI void operator()(Acc& acc, const Unit& u, int wr, int wc, int fr, int fq) const {
        if (u.kh == 0) { mid(acc, u, wr, wc, fr, fq); return; }
        const int row0 = u.pm * 256 + wr * 64 + fr, col0 = u.pn * 256 + wc * 32 + 8 * fq;
        u32x4 w[2][4][2];
#pragma unroll
        for (int ai = 0; ai < 2; ++ai)
#pragma unroll
            for (int m = 0; m < 4; ++m)
#pragma unroll
                for (int bj = 0; bj < 2; ++bj) w[ai][m][bj] = *(const u32x4*)(Gs + (size_t)(row0 + ai * 128 + m * 16) * DM + col0 + bj * 128);
        __builtin_amdgcn_sched_barrier(0);
#pragma unroll
        for (int ai = 0; ai < 2; ++ai)
#pragma unroll
            for (int m = 0; m < 4; ++m)
#pragma unroll
                for (int bj = 0; bj < 2; ++bj) {
                    const size_t o = (size_t)(row0 + ai * 128 + m * 16) * DM + col0 + bj * 128;
                    f32x4 s0, s1; unpack8(w[ai][m][bj], s0, s1);
                    f32x4 v0 = acc[ai][bj][m][0], v1 = acc[ai][bj][m][1];
#pragma unroll
                    for (int j = 0; j < 4; ++j) { v0[j] *= fmaxf(s0[j], 1e-30f); v1[j] *= fmaxf(s1[j], 1e-30f); }
                    *(u32x4*)(Mg + o) = pack8(v0, v1);
                }
    }
};
template <bool IN_BF> struct EpiRes {
    static constexpr int MID = 0;
    const float* xi; const bf16_t* xib; bf16_t* xb; float* ssq;
    DI void operator()(Acc& acc, const Unit& u, int wr, int wc, int fr, int fq) const {
        const int row0 = u.pm * 256 + wr * 64 + fr, col0 = u.pn * 256 + wc * 32 + 8 * fq;
#pragma unroll
        for (int ai = 0; ai < 2; ++ai) {
            f32x4 xv[4][2][2];
            if (IN_BF) {
                u32x4 w[4][2];
#pragma unroll
                for (int m = 0; m < 4; ++m)
#pragma unroll
                    for (int bj = 0; bj < 2; ++bj) w[m][bj] = *(const u32x4*)(xib + (size_t)(row0 + ai * 128 + m * 16) * DM + col0 + bj * 128);
                __builtin_amdgcn_sched_barrier(0);
#pragma unroll
                for (int m = 0; m < 4; ++m)
#pragma unroll
                    for (int bj = 0; bj < 2; ++bj) unpack8(w[m][bj], xv[m][bj][0], xv[m][bj][1]);
            } else {
#pragma unroll
                for (int m = 0; m < 4; ++m)
#pragma unroll
                    for (int bj = 0; bj < 2; ++bj) { const float* p = xi + (size_t)(row0 + ai * 128 + m * 16) * DM + col0 + bj * 128; xv[m][bj][0] = *(const f32x4*)p; xv[m][bj][1] = *(const f32x4*)(p + 4); }
                __builtin_amdgcn_sched_barrier(0);
            }
#pragma unroll
            for (int m = 0; m < 4; ++m) {
                const int row = row0 + ai * 128 + m * 16; float ss = 0.f;
#pragma unroll
                for (int bj = 0; bj < 2; ++bj) {
                    const size_t o = (size_t)row * DM + col0 + bj * 128;
                    const f32x4 v0 = xv[m][bj][0] + acc[ai][bj][m][0], v1 = xv[m][bj][1] + acc[ai][bj][m][1];
                    *(u32x4*)(xb + o) = pack8(v0, v1);
                    ss += (v0[0] * v0[0] + v0[1] * v0[1]) + (v0[2] * v0[2] + v0[3] * v0[3]) + (v1[0] * v1[0] + v1[1] * v1[1]) + (v1[2] * v1[2] + v1[3] * v1[3]);
                }
                ss += __shfl_xor(ss, 16); ss = xhalf_sum(ss);
                if (fq == 0) ssq[(size_t)row * 16 + u.pn * 4 + wc] = ss;
            }
        }
    }
};
struct EpiFfn1 {
    static constexpr int MID = 0;
    const float* ssq; bf16_t* hmid;
    DI void operator()(Acc& acc, const Unit& u, int wr, int wc, int fr, int fq) const {
        const int row0 = u.pm * 256 + wr * 64 + fr, col0 = u.pn * 128 + wc * 32 + 8 * fq;
        f32x4 qv[2][4];
#pragma unroll
        for (int ai = 0; ai < 2; ++ai)
#pragma unroll
            for (int m = 0; m < 4; ++m) qv[ai][m] = *((const f32x4*)(ssq + (size_t)(row0 + ai * 128 + m * 16) * 16) + fq);
        __builtin_amdgcn_sched_barrier(0);
#pragma unroll
        for (int ai = 0; ai < 2; ++ai)
#pragma unroll
            for (int m = 0; m < 4; ++m) {
                const int row = row0 + ai * 128 + m * 16;
                float tot = (qv[ai][m][0] + qv[ai][m][1]) + (qv[ai][m][2] + qv[ai][m][3]);
                tot += __shfl_xor(tot, 16); tot = xhalf_sum(tot);
                const float rs = 1.0f / sqrtf(tot * (1.0f / DM) + RMS_EPS);
                f32x4 v0, v1;
#pragma unroll
                for (int j = 0; j < 4; ++j) {
                    const float g0 = rs * acc[ai][0][m][0][j], g1 = rs * acc[ai][0][m][1][j];
                    v0[j] = g0 * sigmoid_f(g0) * (rs * acc[ai][1][m][0][j]); v1[j] = g1 * sigmoid_f(g1) * (rs * acc[ai][1][m][1][j]);
                }
                *(u32x4*)(hmid + (size_t)row * DFF + col0) = pack8(v0, v1);
            }
    }
};

DI void tr_item(const float* W, int K, int N, bf16_t* WT, int ldt, int koff, int mode, const float* scale, LAS float* scr, int item, int lane) {
    const int nblk = N / 32, kb = item / nblk, nb = item % nblk, k0 = 64 * kb, n0 = 32 * nb;
    float wv[32];
#pragma unroll
    for (int i = 0; i < 32; ++i) { const int kk = 2 * i + (lane >> 5); wv[i] = __builtin_nontemporal_load(W + (size_t)(k0 + kk) * N + n0 + (lane & 31)); }
    float sv = 1.0f; if (scale) sv = scale[k0 + lane];
#pragma unroll
    for (int i = 0; i < 32; ++i) { const int kk = 2 * i + (lane >> 5); const float w = wv[i] * __shfl(sv, kk); scr[kk * 33 + (lane & 31)] = w; }
    asm volatile("s_waitcnt lgkmcnt(0)" ::: "memory");
    const int c = lane & 7;
#pragma unroll
    for (int j = 0; j < 4; ++j) { const int n = (lane >> 3) + 8 * j; const LAS float* s = scr + (8 * c) * 33 + n;
        u32x4 o; o.x = pk_bf16(s[0 * 33], s[1 * 33]); o.y = pk_bf16(s[2 * 33], s[3 * 33]); o.z = pk_bf16(s[4 * 33], s[5 * 33]); o.w = pk_bf16(s[6 * 33], s[7 * 33]);
        const int ng = n0 + n; int rowd;
        if (mode == 0) rowd = ng; else if (mode == 3) { if (ng < 1280) rowd = ng; else { const int n2 = ng - 1280, cg2 = n2 & 1023; rowd = 1280 + (cg2 >> 7) * 256 + (n2 >= 1024 ? 128 : 0) + (cg2 & 127); } }
        else rowd = (ng >> 7) * 256 + (mode == 2 ? 128 : 0) + (ng & 127);
        *(u32x4*)(WT + (size_t)rowd * ldt + koff + k0 + 8 * c) = o; }
    asm volatile("s_waitcnt lgkmcnt(0)" ::: "memory");
}

DI void ssm_tables(LAS unsigned char* lds, int g, int hf, const float* lam_re, const float* lam_im, const float* log_dt, const float* b_re, const float* b_im,
                   const float* c_re, const float* c_im, const float* dvec, bf16_t* Win, bf16_t* Bt2, float* lamT) {
    LAS float* pw = (LAS float*)lds;
    LAS float* bb = pw + 8448;
    LAS float* cc = bb + 4096;
    LAS float* Kt = cc + 2048;
    LAS float* coef = Kt + 8192;
    const int tid = threadIdx.x;
    if (tid < 128) {
        const int dir = tid >> 6, p = tid & 63; const int gi = (dir * 32 + g) * 64 + p;
        const float lr = lam_re[gi], li = lam_im[gi], dt = expf(log_dt[dir * 32 + g]);
        const float mag = expf(lr * dt); float sn, cs; sincosf(li * dt, &sn, &cs);
        const float ar = mag * cs, ai = mag * sn;
        { const float nr = ar - 1.0f, ni = ai, den = lr * lr + li * li;
          coef[(dir * 64 + p) * 2] = (nr * lr + ni * li) / den; coef[(dir * 64 + p) * 2 + 1] = (ni * lr - nr * li) / den; }
        float wr_ = 1.f, wi_ = 0.f;
        for (int tau = 0; tau <= 32; ++tau) {
            pw[((dir * 64 + p) * 33 + tau) * 2] = wr_; pw[((dir * 64 + p) * 33 + tau) * 2 + 1] = wi_;
            if (tau == 32 && hf == 0) { lamT[((g * 2 + dir) * 64 + p) * 2] = wr_; lamT[((g * 2 + dir) * 64 + p) * 2 + 1] = wi_; }
            const float nr = wr_ * ar - wi_ * ai, ni = wr_ * ai + wi_ * ar; wr_ = nr; wi_ = ni;
        }
    }
    __syncthreads();
    for (int idx = tid; idx < 2048; idx += 512) {
        const int dir = idx >> 10, p = (idx >> 4) & 63, h = idx & 15; const int gi = ((dir * 32 + g) * 64 + p) * 16 + h;
        const float br = b_re[gi], bi = b_im[gi], cr = coef[(dir * 64 + p) * 2], ci = coef[(dir * 64 + p) * 2 + 1];
        bb[idx * 2] = cr * br - ci * bi; bb[idx * 2 + 1] = cr * bi + ci * br;
    }
    for (int idx = tid; idx < 1024; idx += 512) {
        const int hh = idx >> 6, p = idx & 63;
        cc[(p * 16 + hh) * 2] = c_re[g * 1024 + idx]; cc[(p * 16 + hh) * 2 + 1] = c_im[g * 1024 + idx];
    }
    __syncthreads();
    {
        const int dir = tid >> 8, tau = (tid >> 3) & 31, hl = tid & 7, hh = 8 * hf + hl;
        float a[16];
#pragma unroll
        for (int h = 0; h < 16; ++h) a[h] = 0.f;
        for (int p = 0; p < 64; ++p) {
            const f32x2 cv = *(const LAS f32x2*)(cc + (p * 16 + hh) * 2), pv = *(const LAS f32x2*)(pw + ((dir * 64 + p) * 33 + tau) * 2);
            const float zr = cv[0] * pv[0] - cv[1] * pv[1], zi = cv[0] * pv[1] + cv[1] * pv[0];
            const LAS f32x4* bp = (const LAS f32x4*)(bb + (dir * 64 + p) * 32);
#pragma unroll
            for (int h2 = 0; h2 < 8; ++h2) { const f32x4 bv = bp[h2]; a[2 * h2] += zr * bv[0] - zi * bv[1]; a[2 * h2 + 1] += zr * bv[2] - zi * bv[3]; }
        }
#pragma unroll
        for (int h = 0; h < 16; ++h) Kt[((dir * 32 + tau) * 8 + hl) * 16 + h] = a[h];
    }
    __syncthreads();
    for (int idx = tid; idx < 8192; idx += 512) {
        const int s = idx & 31, rl = idx >> 5, t = rl >> 3, hl = rl & 7, hh = 8 * hf + hl, row = t * 16 + hh;
        float v[16];
        if (t > s) {
#pragma unroll
            for (int h = 0; h < 16; ++h) v[h] = Kt[(((t - s)) * 8 + hl) * 16 + h];
        } else if (t < s) {
#pragma unroll
            for (int h = 0; h < 16; ++h) v[h] = Kt[((32 + (s - t)) * 8 + hl) * 16 + h];
        } else {
            const float dd = dvec[g * 16 + hh];
#pragma unroll
            for (int h = 0; h < 16; ++h) v[h] = Kt[(hl) * 16 + h] + Kt[((32) * 8 + hl) * 16 + h] + (h == hh ? dd : 0.f);
        }
        u32x4 o0, o1;
        o0.x = pk_bf16(v[0], v[1]); o0.y = pk_bf16(v[2], v[3]); o0.z = pk_bf16(v[4], v[5]); o0.w = pk_bf16(v[6], v[7]);
        o1.x = pk_bf16(v[8], v[9]); o1.y = pk_bf16(v[10], v[11]); o1.z = pk_bf16(v[12], v[13]); o1.w = pk_bf16(v[14], v[15]);
        bf16_t* d = Bt2 + ((size_t)(g * 512 + row)) * UCK + s * 16;
        *(u32x4*)d = o0; *(u32x4*)(d + 8) = o1;
    }
    for (int idx = tid; idx < 256 * 32; idx += 512) {
        const int c8 = idx & 31, rl = idx >> 5, t = rl >> 3, hl = rl & 7, hh = 8 * hf + hl, row = t * 16 + hh;
        const int col = c8 * 8, dir = col >> 7, ri = (col >> 6) & 1, p0 = col & 63;
        const int e = dir ? (CH - t) : (t + 1);
        float v[8];
#pragma unroll
        for (int q = 0; q < 8; ++q) {
            const f32x2 cv = *(const LAS f32x2*)(cc + ((p0 + q) * 16 + hh) * 2), pv = *(const LAS f32x2*)(pw + ((dir * 64 + p0 + q) * 33 + e) * 2);
            v[q] = ri ? -(cv[0] * pv[1] + cv[1] * pv[0]) : (cv[0] * pv[0] - cv[1] * pv[1]);
        }
        u32x4 o; o.x = pk_bf16(v[0], v[1]); o.y = pk_bf16(v[2], v[3]); o.z = pk_bf16(v[4], v[5]); o.w = pk_bf16(v[6], v[7]);
        *(u32x4*)(Bt2 + ((size_t)(g * 512 + row)) * UCK + 512 + col) = o;
    }
    for (int idx = tid; idx < 4096; idx += 512) {
        const int s = idx & 31, cl = idx >> 5, dir = cl >> 6, ri = (cl >> 5) & 1, p = 32 * hf + (cl & 31), comp = dir * 128 + ri * 64 + p;
        const int e = dir ? s : (CH - 1 - s);
        const float pr = pw[((dir * 64 + p) * 33 + e) * 2], pi = pw[((dir * 64 + p) * 33 + e) * 2 + 1];
        const LAS float* bp = bb + (dir * 64 + p) * 32;
        float v[16];
#pragma unroll
        for (int h = 0; h < 16; ++h) { const float br = bp[2 * h], bi = bp[2 * h + 1]; v[h] = ri ? (pr * bi + pi * br) : (pr * br - pi * bi); }
        u32x4 o0, o1;
        o0.x = pk_bf16(v[0], v[1]); o0.y = pk_bf16(v[2], v[3]); o0.z = pk_bf16(v[4], v[5]); o0.w = pk_bf16(v[6], v[7]);
        o1.x = pk_bf16(v[8], v[9]); o1.y = pk_bf16(v[10], v[11]); o1.z = pk_bf16(v[12], v[13]); o1.w = pk_bf16(v[14], v[15]);
        bf16_t* d = Win + ((size_t)(g * 256 + comp)) * 512 + s * 16;
        *(u32x4*)d = o0; *(u32x4*)(d + 8) = o1;
    }
    __syncthreads();
}

#define MFMA32(a, b, c) __builtin_amdgcn_mfma_f32_32x32x16_bf16((a), (b), (c), 0, 0, 0)
DI void attn_phase(LAS unsigned char* lds, const bf16_t* Q, const bf16_t* Kb, const bf16_t* Vb, bf16_t* AS, const float* sink, int u0, int u1) {
    constexpr int KS = 72, VS = 324, NKEY = 320;
    const int tid = threadIdx.x, lane = tid & 63, wid = __builtin_amdgcn_readfirstlane(tid >> 6), r32 = lane & 31, hi = lane >> 5;
    LAS bf16_t* Kl = (LAS bf16_t*)lds; LAS bf16_t* Vl = (LAS bf16_t*)(lds + NKEY * KS * 2);
    u32x4 kreg[5], vreg[5]; bf16x8 qreg[4];
#define ATT_PREFETCH(un) do { const int kvh_ = (un) & 1, qb_ = ((un) >> 1) & 63, b_ = (un) >> 7; _Pragma("unroll") for (int it = 0; it < 5; ++it) { const int idx = tid + 512 * it, key = idx >> 3, piece = idx & 7, kpos = qb_ * 64 - 128 + key; \
        kreg[it] = (u32x4){0u, 0u, 0u, 0u}; vreg[it] = (u32x4){0u, 0u, 0u, 0u}; \
        if (kpos >= 0 && kpos < SEQ) { const size_t base = (size_t)(b_ * SEQ + kpos) * 128 + kvh_ * 64 + piece * 8; kreg[it] = *(const u32x4*)(Kb + base); vreg[it] = *(const u32x4*)(Vb + base); } } \
        { const size_t qrow_ = (size_t)(b_ * SEQ + qb_ * 64 + (wid & 1) * 32 + r32); const int hq_ = kvh_ * 4 + (wid >> 1); \
          _Pragma("unroll") for (int ds = 0; ds < 4; ++ds) qreg[ds] = *(const bf16x8*)(Q + qrow_ * 512 + hq_ * 64 + ds * 16 + hi * 8); } } while (0)
    if (u0 < u1) ATT_PREFETCH(u0);
    for (int unit = u0; unit < u1; ++unit) {
        const int kvh = unit & 1, qb = (unit >> 1) & 63, b = unit >> 7;
        const int q0 = qb * 64, key0 = q0 - 128;
        __syncthreads();
#pragma unroll
        for (int it = 0; it < 5; ++it) {
            const int idx = tid + 512 * it, key = idx >> 3, piece = idx & 7;
            const u32x4 kv = kreg[it], vv = vreg[it];
            *(LAS u32x4*)(Kl + key * KS + piece * 8) = kv;
            LAS bf16_t* vp = Vl + (piece * 8) * VS + key;
            vp[0 * VS] = (bf16_t)(vv.x & 0xffffu); vp[1 * VS] = (bf16_t)(vv.x >> 16); vp[2 * VS] = (bf16_t)(vv.y & 0xffffu); vp[3 * VS] = (bf16_t)(vv.y >> 16);
            vp[4 * VS] = (bf16_t)(vv.z & 0xffffu); vp[5 * VS] = (bf16_t)(vv.z >> 16); vp[6 * VS] = (bf16_t)(vv.w & 0xffffu); vp[7 * VS] = (bf16_t)(vv.w >> 16);
        }
        __syncthreads();
        bf16x8 qf[4];
#pragma unroll
        for (int ds = 0; ds < 4; ++ds) qf[ds] = qreg[ds];
        if (unit + 1 < u1) ATT_PREFETCH(unit + 1);
        const int hq = kvh * 4 + (wid >> 1), qh = wid & 1;
        const int qmin = q0 + qh * 32, qmax = qmin + 31;
        const int qpos = qmin + r32; const size_t qrow = (size_t)(b * SEQ + qpos);
        float mrun = sink[hq] * 1.44269504f, lrun = 1.0f;
        f32x16 o0, o1;
#pragma unroll
        for (int r = 0; r < 16; ++r) { o0[r] = 0.f; o1[r] = 0.f; }
        for (int kt = 0; kt < 5; ++kt) {
            f32x16 s0, s1;
            const int ks0 = key0 + kt * 64, ks1 = ks0 + 32;
            const int st0 = (ks0 + 31 < qmin - 128 || ks0 > qmax + 128 || ks0 + 31 < 0 || ks0 >= SEQ) ? 0 : ((ks0 >= qmax - 128 && ks0 + 31 <= qmin + 128 && ks0 >= 0 && ks0 + 31 < SEQ) ? 1 : 2);
            const int st1 = (ks1 + 31 < qmin - 128 || ks1 > qmax + 128 || ks1 + 31 < 0 || ks1 >= SEQ) ? 0 : ((ks1 >= qmax - 128 && ks1 + 31 <= qmin + 128 && ks1 >= 0 && ks1 + 31 < SEQ) ? 1 : 2);
            float mx = mrun;
            bf16x8 kfa[4], kfb[4]; u32x2 vlo[4][2], vhi[4][2];
#pragma unroll
            for (int ds = 0; ds < 4; ++ds) { kfa[ds] = *(const LAS bf16x8*)(Kl + (kt * 64 + r32) * KS + ds * 16 + hi * 8); kfb[ds] = *(const LAS bf16x8*)(Kl + (kt * 64 + 32 + r32) * KS + ds * 16 + hi * 8); }
#pragma unroll
            for (int j = 0; j < 4; ++j) { const int kk = kt * 64 + (j >> 1) * 32 + (j & 1) * 16 + 4 * hi;
                vlo[j][0] = *(const LAS u32x2*)(Vl + (r32) * VS + kk); vhi[j][0] = *(const LAS u32x2*)(Vl + (r32) * VS + kk + 8);
                vlo[j][1] = *(const LAS u32x2*)(Vl + (32 + r32) * VS + kk); vhi[j][1] = *(const LAS u32x2*)(Vl + (32 + r32) * VS + kk + 8); }
            __builtin_amdgcn_sched_barrier(0);
#define ATT_SUB(sv, stv, kfx) \
            if (stv == 0) { _Pragma("unroll") for (int r = 0; r < 16; ++r) sv[r] = -1e30f; } \
            else { \
                _Pragma("unroll") for (int r = 0; r < 16; ++r) sv[r] = 0.f; \
                _Pragma("unroll") for (int ds = 0; ds < 4; ++ds) sv = MFMA32(kfx[ds], qf[ds], sv); \
                if (stv == 2) { const int kb_ = key0 + kt * 64 + ((&kfx[0] == &kfb[0]) ? 32 : 0) + 4 * hi; \
                    _Pragma("unroll") for (int r = 0; r < 16; ++r) { const int kp = kb_ + (r & 3) + 8 * (r >> 2); const int d = qpos - kp; \
                        const bool ok = (d <= 128) && (d >= -128) && (kp >= 0) && (kp < SEQ); sv[r] = ok ? sv[r] : -1e30f; } } \
                _Pragma("unroll") for (int r = 0; r < 16; ++r) mx = fmaxf(mx, sv[r]); \
            }
            ATT_SUB(s0, st0, kfa)
            ATT_SUB(s1, st1, kfb)
#undef ATT_SUB
            mx = xhalf_max(mx);
            const float alpha = __builtin_amdgcn_exp2f(mrun - mx); mrun = mx;
            float sum = 0.f;
#pragma unroll
            for (int r = 0; r < 16; ++r) { s0[r] = __builtin_amdgcn_exp2f(s0[r] - mx); s1[r] = __builtin_amdgcn_exp2f(s1[r] - mx); sum += s0[r] + s1[r]; }
            sum = xhalf_sum(sum);
            lrun = lrun * alpha + sum;
            if (__builtin_amdgcn_ballot_w64(alpha != 1.0f) != 0ull) {
#pragma unroll
                for (int r = 0; r < 16; ++r) { o0[r] *= alpha; o1[r] *= alpha; }
            }
#pragma unroll
            for (int j = 0; j < 4; ++j) {
                if ((j < 2 ? st0 : st1) == 0) continue;
                u32x4 pw4;
                if (j < 2) { pw4.x = pk_bf16(s0[8 * (j & 1) + 0], s0[8 * (j & 1) + 1]); pw4.y = pk_bf16(s0[8 * (j & 1) + 2], s0[8 * (j & 1) + 3]); pw4.z = pk_bf16(s0[8 * (j & 1) + 4], s0[8 * (j & 1) + 5]); pw4.w = pk_bf16(s0[8 * (j & 1) + 6], s0[8 * (j & 1) + 7]); }
                else       { pw4.x = pk_bf16(s1[8 * (j & 1) + 0], s1[8 * (j & 1) + 1]); pw4.y = pk_bf16(s1[8 * (j & 1) + 2], s1[8 * (j & 1) + 3]); pw4.z = pk_bf16(s1[8 * (j & 1) + 4], s1[8 * (j & 1) + 5]); pw4.w = pk_bf16(s1[8 * (j & 1) + 6], s1[8 * (j & 1) + 7]); }
                const bf16x8 pf = __builtin_bit_cast(bf16x8, pw4);
                { const u32x4 vw = {vlo[j][0].x, vlo[j][0].y, vhi[j][0].x, vhi[j][0].y}; o0 = MFMA32(__builtin_bit_cast(bf16x8, vw), pf, o0); }
                { const u32x4 vw = {vlo[j][1].x, vlo[j][1].y, vhi[j][1].x, vhi[j][1].y}; o1 = MFMA32(__builtin_bit_cast(bf16x8, vw), pf, o1); }
            }
        }
        const float inv = 1.0f / lrun;
        bf16_t* op = AS + qrow * DM + hq * 64 + 4 * hi;
#pragma unroll
        for (int g4 = 0; g4 < 4; ++g4) {
            u32x2 w0, w1;
            w0.x = pk_bf16(o0[4 * g4] * inv, o0[4 * g4 + 1] * inv); w0.y = pk_bf16(o0[4 * g4 + 2] * inv, o0[4 * g4 + 3] * inv);
            w1.x = pk_bf16(o1[4 * g4] * inv, o1[4 * g4 + 1] * inv); w1.y = pk_bf16(o1[4 * g4 + 2] * inv, o1[4 * g4 + 3] * inv);
            *(u32x2*)(op + 8 * g4) = w0; *(u32x2*)(op + 32 + 8 * g4) = w1;
        }
    }
    __syncthreads();
}

DI void scan_blk(LAS unsigned char* lds, const float* F, const float* lamT, bf16_t* ucat, int blk) {
    LAS float* E = (LAS float*)lds;
    const int tid = threadIdx.x, seg = tid >> 7, cl = tid & 127;
    {
        const int chain = blk * 128 + cl, p = chain & 63, dir = (chain >> 6) & 1, b = (chain >> 7) & 7, g = chain >> 10;
        const float ar = lamT[((g * 2 + dir) * 64 + p) * 2], ai = lamT[((g * 2 + dir) * 64 + p) * 2 + 1];
        const int comp = dir * 128 + p, rowbase = g * NROW + b * 128;
        float pr[32], pi[32]; float sr = 0.f, si = 0.f;
#pragma unroll
        for (int jj = 0; jj < 32; ++jj) {
            const int j = seg * 32 + jj, ci = dir ? 127 - j : j;
            const float fr = F[(size_t)(rowbase + ci) * 256 + comp], fi = F[(size_t)(rowbase + ci) * 256 + comp + 64];
            pr[jj] = sr; pi[jj] = si;
            const float nr = ar * sr - ai * si + fr, ni = ar * si + ai * sr + fi; sr = nr; si = ni;
        }
        __syncthreads();
        E[(seg * 128 + cl) * 2] = sr; E[(seg * 128 + cl) * 2 + 1] = si;
        __syncthreads();
        float a32r = ar, a32i = ai;
#pragma unroll
        for (int q = 0; q < 5; ++q) { const float nr = a32r * a32r - a32i * a32i, ni = 2.f * a32r * a32i; a32r = nr; a32i = ni; }
        float cr = 0.f, ci_ = 0.f;
#pragma unroll
        for (int s = 0; s < 3; ++s) if (s < seg) { const float er = E[(s * 128 + cl) * 2], ei = E[(s * 128 + cl) * 2 + 1]; const float nr = a32r * cr - a32i * ci_ + er, ni = a32r * ci_ + a32i * cr + ei; cr = nr; ci_ = ni; }
        float wr_ = 1.f, wi_ = 0.f;
#pragma unroll
        for (int jj = 0; jj < 32; ++jj) {
            const int j = seg * 32 + jj, ci = dir ? 127 - j : j;
            const float outr = pr[jj] + wr_ * cr - wi_ * ci_, outi = pi[jj] + wr_ * ci_ + wi_ * cr;
            bf16_t* d = ucat + (size_t)(rowbase + ci) * UCK + 512 + comp;
            d[0] = (bf16_t)(pk_bf16(outr, 0.f) & 0xffffu); d[64] = (bf16_t)(pk_bf16(outi, 0.f) & 0xffffu);
            const float nr = wr_ * ar - wi_ * ai, ni = wr_ * ai + wi_ * ar; wr_ = nr; wi_ = ni;
        }
    }
    __syncthreads();
}

#define XB_TMO      128
#define XB_XCNT(j)  (256  + 64 * (j))
#define XB_XSUB(j)  (1280 + 64 * (j))
#define XB_XGEN(j)  (2304 + 64 * (j))
#define XB_TOP      3328
#define XB_TOPGEN   3392
#define XCD_BAR_WORDS 3456
#define XB_SPIN_CAP (1u << 18)
DI unsigned xb_ld(unsigned* p)              { return __hip_atomic_load(p, __ATOMIC_RELAXED, __HIP_MEMORY_SCOPE_AGENT); }
DI unsigned xb_add(unsigned* p, unsigned v) { return __hip_atomic_fetch_add(p, v, __ATOMIC_RELAXED, __HIP_MEMORY_SCOPE_AGENT); }
DI unsigned xb_xcc_id() { return (unsigned)__builtin_amdgcn_s_getreg((3 << 11) | 20) & 0xFu; }
#define XB_SPIN(cond, bar) do { unsigned _sp = 0; while (cond) { __builtin_amdgcn_s_sleep(1); \
    if ((++_sp & 255u) == 0u) { if (xb_ld(&(bar)[XB_TMO])) break; if (_sp > XB_SPIN_CAP) { atomicAdd(&(bar)[XB_TMO], 1u); break; } } } } while (0)
struct XcdBarrier { unsigned* bar; unsigned x; volatile LAS unsigned* st; };
DI XcdBarrier xcd_barrier_post(unsigned* bar, volatile LAS unsigned* st) {
    XcdBarrier b; b.bar = bar; b.x = xb_xcc_id(); b.st = st;
    if (threadIdx.x == 0) (void)xb_add(&bar[XB_XCNT(b.x)], 1u);
    return b;
}
DI void xcd_barrier_complete(unsigned* bar, unsigned x, unsigned& nloc, unsigned& nx) {
    const unsigned G = gridDim.x * gridDim.y * gridDim.z;
    unsigned sum, cnt, mine, sp = 0u;
    for (;;) {
        sum = 0u; cnt = 0u; mine = 0u;
#pragma unroll
        for (unsigned j = 0; j < 16; ++j) { const unsigned c = xb_ld(&bar[XB_XCNT(j)]); sum += c; cnt += (c > 0u) ? 1u : 0u; mine = (j == x) ? c : mine; }
        if (sum == G) break;
        __builtin_amdgcn_s_sleep(1);
        if ((++sp & 255u) == 0u) { if (xb_ld(&bar[XB_TMO])) break; if (sp > XB_SPIN_CAP) { atomicAdd(&bar[XB_TMO], 1u); break; } }
    }
    nloc = mine > 0u ? mine : 1u; nx = cnt > 0u ? cnt : 1u;
}
DI void xcd_barrier(const XcdBarrier& b) {
    asm volatile("s_waitcnt vmcnt(0)" ::: "memory");
    __syncthreads();
    if (threadIdx.x == 0) {
        unsigned* bar = b.bar;
        __builtin_amdgcn_s_waitcnt(0);
        unsigned nloc = b.st[0], nx = b.st[1];
        if (nloc == 0u) { xcd_barrier_complete(bar, b.x, nloc, nx); b.st[0] = nloc; b.st[1] = nx; }
        const unsigned old = xb_add(&bar[XB_XSUB(b.x)], 1u);
        const unsigned gen = old / nloc;
        if (old + 1u == (gen + 1u) * nloc) {
            __builtin_amdgcn_fence(__ATOMIC_RELEASE, "agent");
            asm volatile("s_waitcnt vmcnt(0)" ::: "memory");
            const unsigned og = xb_add(&bar[XB_TOP], 1u);
            const unsigned tg = og / nx;
            if (og + 1u == (tg + 1u) * nx) xb_add(&bar[XB_TOPGEN], 1u);
            else XB_SPIN(xb_ld(&bar[XB_TOPGEN]) == tg, bar);
            __builtin_amdgcn_fence(__ATOMIC_ACQUIRE, "agent");
            xb_add(&bar[XB_XGEN(b.x)], 1u);
            asm volatile("s_waitcnt vmcnt(0)" ::: "memory");
        } else {
            XB_SPIN(xb_ld(&bar[XB_XGEN(b.x)]) == gen, bar);
            __builtin_amdgcn_fence(__ATOMIC_ACQUIRE, "agent");
            asm volatile("s_waitcnt vmcnt(0)" ::: "memory");
        }
    }
    __syncthreads();
}

struct Args { const float* in[21]; float* out; unsigned char* ws; int ph_lo, ph_hi, li, pad; };
constexpr int NPHASE = 11;

__global__ void __launch_bounds__(512, 2) mk_fwd(Args args) {
    extern __shared__ __attribute__((aligned(16))) unsigned char lds_raw[];
    LAS unsigned char* lds = (LAS unsigned char*)lds_raw;
    const int tid = threadIdx.x, lane = tid & 63, wid = __builtin_amdgcn_readfirstlane(tid >> 6);
    const int G = gridDim.x, bx = blockIdx.x;
    const int gw = bx * 8 + wid, NGW = G * 8;
    unsigned char* ws = args.ws;
    const float* x = args.in[0];
    bf16_t* WinT = (bf16_t*)(ws + WS_WINT); bf16_t* SWin = (bf16_t*)(ws + WS_SWIN); bf16_t* Bt2 = (bf16_t*)(ws + WS_BT2); bf16_t* WgluT = (bf16_t*)(ws + WS_WGLUT);
    bf16_t* BtCat = (bf16_t*)(ws + WS_BTCAT); bf16_t* WoT = (bf16_t*)(ws + WS_WOT); bf16_t* BtFfn = (bf16_t*)(ws + WS_BTFFN); bf16_t* WdT = (bf16_t*)(ws + WS_WDT);
    float* rope = (float*)(ws + WS_ROPE); float* lamT = (float*)(ws + WS_LAMT); float* ssq1 = (float*)(ws + WS_SSQ1); float* ssq2 = (float*)(ws + WS_SSQ2);
    bf16_t* H1 = (bf16_t*)(ws + WS_H1); bf16_t* AS = (bf16_t*)(ws + WS_AS); bf16_t* Qb = (bf16_t*)(ws + WS_Q); bf16_t* yg = (bf16_t*)(ws + WS_YG);
    bf16_t* Kb = (bf16_t*)(ws + WS_K); bf16_t* Vb = (bf16_t*)(ws + WS_V); bf16_t* ucat = (bf16_t*)(ws + WS_UCAT); bf16_t* Mg = (bf16_t*)(ws + WS_MG);
    float* Fst = (float*)(ws + WS_F); bf16_t* Ga = (bf16_t*)(ws + WS_GA); bf16_t* Gs = (bf16_t*)(ws + WS_GS); bf16_t* Xb = (bf16_t*)(ws + WS_XB); bf16_t* Hmid = (bf16_t*)(ws + WS_HMID);
    float* out = args.out; bf16_t* X2b = (bf16_t*)(ws + WS_GA);
    const int lo = args.ph_lo, hi = args.ph_hi;
    if (lo < 0) cg::this_grid().sync();
    volatile LAS unsigned* xst = (volatile LAS unsigned*)(lds + 131072);
    if (tid == 0) { xst[0] = 0u; xst[1] = 0u; xst[2] = 0u; xst[3] = 0u; }
    __syncthreads();
    const XcdBarrier xbar = xcd_barrier_post((unsigned*)(ws + WS_BAR) + args.li * XCD_BAR_WORDS, xst);
#ifndef PHASE_MASK
#define PHASE_MASK 0x7ff
#endif
#define IN(k) (((PHASE_MASK >> (k)) & 1) && lo <= (k) && (k) < hi)
#if MK_PER_PHASE
#define SEAM(k) do { } while (0)
#else
#define SEAM(k) do { if (IN(k) && IN((k) + 1)) xcd_barrier(xbar); } while (0)
#endif

#define DEFERRED_TRANSPOSES(it0, it1) do { if (bx >= 128) { LAS float* scr = (LAS float*)(lds + wid * 8448); \
        constexpr int I_GLU = 8 * 16, I_AB = 8 * 32, I_SB = 8 * 32, I_O = 16 * 32, I_G = 16 * 88, I_U = 16 * 88; \
        for (int it = (it0) + (bx - 128) * 8 + wid; it < (it1); it += (G - 128) * 8) { int r = it; \
            if (r < I_GLU) { tr_item(args.in[12], 512, 512, WgluT, 512, 0, 0, nullptr, scr, r, lane); continue; } r -= I_GLU; \
            if (r < I_AB) { tr_item(args.in[13], 512, DM, BtCat, DM, 0, 0, nullptr, scr, r, lane); continue; } r -= I_AB; \
            if (r < I_SB) { tr_item(args.in[14], 512, DM, BtCat, DM, 512, 0, nullptr, scr, r, lane); continue; } r -= I_SB; \
            if (r < I_O) { tr_item(args.in[15], DM, DM, WoT, DM, 0, 0, nullptr, scr, r, lane); continue; } r -= I_O; \
            if (r < I_G) { tr_item(args.in[17], DM, DFF, BtFfn, DM, 0, 1, args.in[16], scr, r, lane); continue; } r -= I_G; \
            if (r < I_U) { tr_item(args.in[18], DM, DFF, BtFfn, DM, 0, 2, args.in[16], scr, r, lane); continue; } r -= I_U; \
            tr_item(args.in[19], DFF, DM, WdT, DFF, 0, 0, nullptr, scr, r, lane); } \
        __syncthreads(); } } while (0)
    constexpr int N_DEFERRED = 8 * 16 + 8 * 32 + 8 * 32 + 16 * 32 + 16 * 88 + 16 * 88 + 44 * 32, N_DEF_P1 = N_DEFERRED;

    if (IN(0)) {
        if (bx < 64) ssm_tables(lds, bx >> 1, bx & 1, args.in[4], args.in[5], args.in[6], args.in[7], args.in[8], args.in[9], args.in[10], args.in[11], SWin, Bt2, lamT);
        else if (bx < 128) {
            const int i = (bx - 64) * 512 + tid;
            const int pos = i >> 3, j = i & 7; const float inv = powf(500000.0f, -(float)j / 8.0f); float sn, cs; sincosf((float)pos * inv, &sn, &cs);
            rope[pos * 16 + j] = cs; rope[pos * 16 + 8 + j] = sn;
        }
        {
            LAS float* scr = (LAS float*)(lds + wid * 8448);
            constexpr int NTR = 16 * 104, NITEMS = NTR + NTOK / 4;
            const float* g1 = args.in[1];
            f32x4 g1v[4];
#pragma unroll
            for (int j = 0; j < 4; ++j) g1v[j] = *((const f32x4*)g1 + lane + 64 * j);
            const int nslot = (G - 64) * 16 + 256;
            const int s0_ = bx >= 64 ? ((bx - 64) * 8 + wid) * 2 : (G - 64) * 16 + bx * 4 + (wid & 3), ns_ = bx >= 64 ? 2 : (wid < 4 ? 1 : 0);
            for (int itb = 0; itb < NITEMS; itb += nslot)
            for (int sub = 0; sub < ns_; ++sub) {
                const int it = itb + s0_ + sub; if (it >= NITEMS) break;
                int r = it;
                if (r >= NTR) {
                    const int m0 = (r - NTR) * 4;
                    f32x4 v[4][4]; float ssv[4];
#pragma unroll
                    for (int q = 0; q < 4; ++q) { const f32x4* xr = (const f32x4*)(x + (size_t)(m0 + q) * DM) + lane;
#pragma unroll
                        for (int j = 0; j < 4; ++j) v[q][j] = __builtin_nontemporal_load(xr + 64 * j); }
#pragma unroll
                    for (int q = 0; q < 4; ++q) { float s_ = 0.f;
#pragma unroll
                        for (int j = 0; j < 4; ++j) s_ += (v[q][j][0] * v[q][j][0] + v[q][j][1] * v[q][j][1]) + (v[q][j][2] * v[q][j][2] + v[q][j][3] * v[q][j][3]);
                        ssv[q] = 1.0f / sqrtf(wave_sum(s_) * (1.0f / DM) + RMS_EPS); }
#pragma unroll
                    for (int j = 0; j < 4; ++j) { const f32x4 gv = g1v[j];
#pragma unroll
                        for (int q = 0; q < 4; ++q) { const f32x4 w = v[q][j] * ssv[q] * gv; u32x2 o; o.x = pk_bf16(w[0], w[1]); o.y = pk_bf16(w[2], w[3]); *((u32x2*)(H1 + (size_t)(m0 + q) * DM) + lane + 64 * j) = o; } }
                    continue;
                }
                tr_item(args.in[2], DM, INC, WinT, DM, 0, 3, nullptr, scr, r, lane);
            }
        }
        __syncthreads();
    }
    SEAM(0);
    if (IN(1)) {
        pg8::Gemm g{H1, WinT, DM, DM, DM, 16, 0, 0}; pg8::StaticOrder S; S.init(NTOK / 256, INC / 256, G, bx);
        EpiIn E{Qb, Kb, Vb, ucat, Ga, Gs, rope};
        pg8::gemm_phase(lds, g, S, E);
        DEFERRED_TRANSPOSES(0, N_DEF_P1);
    }
    SEAM(1);
    if (IN(2)) {
        {
            pg8::Gemm g{ucat, SWin, UCK, 512, 512, 16, 0, 0}; pg8::GroupOrder S; S.init(32, 4, 1, G, bx); EpiF E{Fst}; pg8::gemm_phase(lds, g, S, E);
            for (int i = 0; ; ++i) { Unit u; if (!S.next(i, u)) break;
                asm volatile("s_waitcnt vmcnt(0)" ::: "memory"); __syncthreads();
                scan_blk(lds, Fst, lamT, ucat, u.pm * 2); scan_blk(lds, Fst, lamT, ucat, u.pm * 2 + 1); }
        }
        DEFERRED_TRANSPOSES(N_DEF_P1, N_DEFERRED);
        {
            int u0, u1;
            if (G == 256) { if (bx < 128) { u0 = bx * 3; u1 = u0 + 3; } else { u0 = 384 + (bx - 128) * 5; u1 = u0 + 5; } }
            else { const int per = (1024 + G - 1) / G; u0 = bx * per; u1 = u0 + per < 1024 ? u0 + per : 1024; if (u0 > 1024) u0 = 1024; }
            attn_phase(lds, Qb, Kb, Vb, AS, args.in[3], u0, u1);
        }
    }
    SEAM(2);
    if (IN(4)) { pg8::Gemm g{ucat, Bt2, UCK, UCK, UCK, 16, 0, 0}; pg8::GroupOrder S; S.init(32, 4, 2, G, bx); EpiY E{yg}; pg8::gemm_phase(lds, g, S, E); }
    SEAM(4);
    if (IN(5)) { pg8::Gemm g{yg, WgluT, 16, 512, 512, NTOK * 16, 0, 0}; pg8::StaticOrder S; S.init(NTOK / 256, 2, G, bx); EpiGlu E{yg, AS}; pg8::gemm_phase(lds, g, S, E); }
    SEAM(5);
    if (IN(6)) { pg8::Gemm g{AS, BtCat, DM, DM, 512, 16, 1024, 1024}; pg8::StaticOrder S; S.init(NTOK / 256, 4, G, bx, 1); EpiMerge E{Ga, Gs, Mg}; pg8::gemm_phase(lds, g, S, E); }
    SEAM(6);
    if (IN(7)) { pg8::Gemm g{Mg, WoT, DM, DM, DM, 16, 0, 0}; pg8::StaticOrder S; S.init(NTOK / 256, 4, G, bx); EpiRes<false> E{x, nullptr, Xb, ssq1}; pg8::gemm_phase(lds, g, S, E); }
    SEAM(7);
    if (IN(8)) { pg8::Gemm g{Xb, BtFfn, DM, DM, DM, 16, 0, 0}; pg8::StaticOrder S; S.init(NTOK / 256, 2 * DFF / 256, G, bx); EpiFfn1 E{ssq1, Hmid}; pg8::gemm_phase(lds, g, S, E); }
    SEAM(8);
    if (IN(9)) { pg8::Gemm g{Hmid, WdT, DFF, DFF, DFF, 16, 0, 0}; pg8::StaticOrder S; S.init(NTOK / 256, 4, G, bx); EpiRes<true> E{nullptr, Xb, X2b, ssq2}; pg8::gemm_phase(lds, g, S, E); }
    SEAM(9);
#ifdef MK_EXTRA_SYNCS
    if (IN(9)) for (int e = 0; e < MK_EXTRA_SYNCS; ++e) xcd_barrier(xbar);
#endif
    if (IN(10)) {
        const float* gf = args.in[20];
        f32x4 gv[4];
#pragma unroll
        for (int j = 0; j < 4; ++j) gv[j] = *((const f32x4*)gf + lane + 64 * j);
        for (int m0 = gw * 4; m0 < NTOK; m0 += NGW * 4) {
            u32x2 w[4][4]; float rsv[4];
#pragma unroll
            for (int q = 0; q < 4; ++q) {
                const u32x2* xr = (const u32x2*)(X2b + (size_t)(m0 + q) * DM) + lane;
#pragma unroll
                for (int j = 0; j < 4; ++j) w[q][j] = __builtin_nontemporal_load(xr + 64 * j);
                rsv[q] = ssq2[(size_t)(m0 + q) * 16 + (lane & 15)];
            }
#pragma unroll
            for (int q = 0; q < 4; ++q) {
                float tot = rsv[q]; tot += __shfl_xor(tot, 1); tot += __shfl_xor(tot, 2); tot += __shfl_xor(tot, 4); tot += __shfl_xor(tot, 8);
                const float rs = 1.0f / sqrtf(tot * (1.0f / DM) + RMS_EPS);
                f32x4* orow = (f32x4*)(out + (size_t)(m0 + q) * DM) + lane;
#pragma unroll
                for (int j = 0; j < 4; ++j) { f32x4 v; v[0] = bf_lo(w[q][j].x); v[1] = bf_hi(w[q][j].x); v[2] = bf_lo(w[q][j].y); v[3] = bf_hi(w[q][j].y); __builtin_nontemporal_store(v * rs * gv[j], orow + 64 * j); }
            }
        }
    }
}

extern "C" void kernel_launch(void* const* d_in, const int* in_sizes, int n_in, void* d_out, int out_size, void* d_ws, size_t ws_size, hipStream_t stream) {
    static int grid = 0;
    if (grid == 0) {
        if (n_in != 21 || in_sizes[0] != NTOK * DM || out_size != NTOK * DM || ws_size < WS_END) {
            fprintf(stderr, "kernel_launch: unexpected shapes (n_in %d, in0 %d, out %d, ws %zu); nothing launched\n", n_in, n_in > 0 ? in_sizes[0] : -1, out_size, ws_size); grid = -1; return; }
        int dev = 0, cus = 0, per_cu = 0;
        hipGetDevice(&dev); hipDeviceGetAttribute(&cus, hipDeviceAttributeMultiprocessorCount, dev);
        if (hipFuncSetAttribute((const void*)mk_fwd, hipFuncAttributeMaxDynamicSharedMemorySize, LDS_BYTES) != hipSuccess) { fprintf(stderr, "kernel_launch: hipFuncSetAttribute failed\n"); grid = -1; return; }
        if (hipOccupancyMaxActiveBlocksPerMultiprocessor(&per_cu, (const void*)mk_fwd, 512, LDS_BYTES) != hipSuccess || per_cu < 1) { fprintf(stderr, "kernel_launch: occupancy query says %d\n", per_cu); per_cu = 1; }
        (void)hipGetLastError();
        grid = cus * 1;
    }
    if (grid < 0) return;
    Args a{};
    for (int i = 0; i < 21; ++i) a.in[i] = (const float*)d_in[i];
    a.out = (float*)d_out; a.ws = (unsigned char*)d_ws;
    static const int ranges[][2] = {MK_RANGES};
    static_assert(sizeof(ranges) / sizeof(ranges[0]) <= 4, "one barrier-word region per launch");
    if (hipMemsetAsync((char*)d_ws + WS_BAR, 0, 4 * XCD_BAR_WORDS * 4 + 1024, stream) != hipSuccess) { fprintf(stderr, "kernel_launch: hipMemsetAsync failed\n"); return; }
    for (unsigned li = 0; li < sizeof(ranges) / sizeof(ranges[0]); ++li) {
        a.ph_lo = ranges[li][0]; a.ph_hi = ranges[li][1]; a.li = (int)li;
        void* kargs[] = {&a};
        hipError_t e = hipLaunchCooperativeKernel((const void*)mk_fwd, dim3(grid), dim3(512), kargs, LDS_BYTES, stream);
        if (e != hipSuccess) fprintf(stderr, "kernel_launch: cooperative launch failed: %s (grid %d)\n", hipGetErrorString(e), grid);
    }
}
```

```cpp
#include <hip/hip_runtime.h>
#include <hip/hip_cooperative_groups.h>
#include <cstdio>
#include <cstdint>
namespace cg = cooperative_groups;

#ifndef MK_RANGES
#define MK_RANGES {0, 11}
#endif
#ifndef MK_PER_PHASE
#define MK_PER_PHASE 0
#endif

#define LAS __attribute__((address_space(3)))
typedef unsigned short bf16_t;
typedef short bf16x8 __attribute__((ext_vector_type(8)));
typedef float f32x4 __attribute__((ext_vector_type(4)));
typedef float f32x2 __attribute__((ext_vector_type(2)));
typedef float f32x16 __attribute__((ext_vector_type(16)));
typedef unsigned u32x4 __attribute__((ext_vector_type(4)));
typedef unsigned u32x2 __attribute__((ext_vector_type(2)));
typedef __bf16 bf2_t __attribute__((ext_vector_type(2)));
#define DI __device__ __forceinline__

constexpr int NTOK = 32768, DM = 1024, SEQ = 4096, INC = 3328, DFF = 2816;
constexpr int CH = 32;
constexpr int NROW = NTOK / CH;
constexpr int UCK = 768;
constexpr float RMS_EPS = 1e-6f;

constexpr size_t MiB = 1u << 20;
constexpr size_t WS_WINT = 0;
constexpr size_t WS_SWIN = WS_WINT + (size_t)INC * DM * 2;
constexpr size_t WS_BT2 = WS_SWIN + (size_t)32 * 256 * 512 * 2;
constexpr size_t WS_WGLUT = WS_BT2 + (size_t)32 * 512 * 768 * 2;
constexpr size_t WS_BTCAT = WS_WGLUT + (size_t)512 * 512 * 2;
constexpr size_t WS_WOT = WS_BTCAT + (size_t)DM * DM * 2;
constexpr size_t WS_BTFFN = WS_WOT + (size_t)DM * DM * 2;
constexpr size_t WS_WDT = WS_BTFFN + (size_t)2 * DFF * DM * 2;
constexpr size_t WS_ROPE = WS_WDT + (size_t)DM * DFF * 2;
constexpr size_t WS_LAMT = WS_ROPE + (size_t)SEQ * 16 * 4;
constexpr size_t WS_SSQ1 = WS_LAMT + (size_t)32 * 2 * 64 * 2 * 4;
constexpr size_t WS_SSQ2 = WS_SSQ1 + (size_t)NTOK * 16 * 4;
constexpr size_t WS_BAR = WS_SSQ2 + (size_t)NTOK * 16 * 4;
constexpr size_t WS_WEND = WS_BAR + 4 * 3456 * 4 + 1024;
static_assert(WS_WEND <= 72 * MiB, "weights region");
constexpr size_t WS_H1 = 72 * MiB;
constexpr size_t WS_AS = WS_H1;
constexpr size_t WS_Q = 136 * MiB;
constexpr size_t WS_YG = WS_Q;
constexpr size_t WS_K = 168 * MiB;
constexpr size_t WS_V = 176 * MiB;
constexpr size_t WS_UCAT = 184 * MiB;
constexpr size_t WS_MG = WS_UCAT;
constexpr size_t WS_F = 232 * MiB;
constexpr size_t WS_GA = 264 * MiB;
constexpr size_t WS_GS = 328 * MiB;
constexpr size_t WS_XB = 392 * MiB;
constexpr size_t WS_HMID = 72 * MiB;
constexpr size_t WS_END = 456 * MiB;
static_assert(WS_HMID + (size_t)NTOK * DFF * 2 <= WS_GA, "hmid overlay");

constexpr int LDS_BYTES = 147456;

DI unsigned pk_bf16(float lo, float hi) { f32x2 v = {lo, hi}; bf2_t b = __builtin_convertvector(v, bf2_t); return __builtin_bit_cast(unsigned, b); }
DI float bf_lo(unsigned u) { return __uint_as_float(u << 16); }
DI float bf_hi(unsigned u) { return __uint_as_float(u & 0xffff0000u); }
DI u32x4 pack8(const f32x4& a, const f32x4& b) { u32x4 w; w.x = pk_bf16(a[0], a[1]); w.y = pk_bf16(a[2], a[3]); w.z = pk_bf16(b[0], b[1]); w.w = pk_bf16(b[2], b[3]); return w; }
DI void unpack8(const u32x4& w, f32x4& a, f32x4& b) { a[0] = bf_lo(w.x); a[1] = bf_hi(w.x); a[2] = bf_lo(w.y); a[3] = bf_hi(w.y); b[0] = bf_lo(w.z); b[1] = bf_hi(w.z); b[2] = bf_lo(w.w); b[3] = bf_hi(w.w); }
DI float xhalf_sum(float x) { const unsigned u = __float_as_uint(x); const auto r = __builtin_amdgcn_permlane32_swap(u, u, false, false); return __uint_as_float(r[0]) + __uint_as_float(r[1]); }
DI float xhalf_max(float x) { const unsigned u = __float_as_uint(x); const auto r = __builtin_amdgcn_permlane32_swap(u, u, false, false); return fmaxf(__uint_as_float(r[0]), __uint_as_float(r[1])); }
DI float sigmoid_f(float x) { return __builtin_amdgcn_rcpf(1.0f + __expf(-x)); }
DI float gelu_tanh(float x) { const float t = 1.5957691216f * (x + 0.044715f * x * x * x); return x * sigmoid_f(t); }
DI float wave_sum(float v) {
#pragma unroll
    for (int o = 1; o < 32; o <<= 1) v += __shfl_xor(v, o);
    return xhalf_sum(v);
}

namespace pg8 {
constexpr int BM = 256, BK = 64, HALF = 128, HTB = HALF * BK * 2, NXCD = 8, WGM = 8;
DI int lds_byte(int r, int c) { const int st = (r >> 4) * 2 + (c >> 5), rr = r & 15, cc = c & 31, ob = rr * 64 + cc * 2; return st * 1024 + (ob ^ (((ob >> 9) & 1) << 5)); }
DI void stage_rc(int b, int& R, int& C) { const int st = b / 1024, sb = b % 1024, swz = sb ^ (((sb >> 9) & 1) << 5); R = (st >> 1) * 16 + swz / 64; C = (st & 1) * 32 + (swz % 64) / 2; }
DI int perm32(int rho) { const int n = rho >> 4, i = rho & 15; return 8 * (i >> 2) + 4 * n + (i & 3); }

struct Unit { int pm, pn, kh; };
struct Gemm { const bf16_t* A; const bf16_t* Bt; int lda, ldb, K, ksubA; int kofsA, kofsB; };

DI int xcd_remap(int wgid, int nwg) { const int q = nwg / NXCD, r = nwg % NXCD, xcd = wgid % NXCD, off = wgid / NXCD; return (xcd < r ? xcd * (q + 1) : r * (q + 1) + (xcd - r) * q) + off; }
struct StaticOrder {
    int nM, nN, nwg, G, c, pair;
    DI void init(int nM_, int nN_, int G_, int c_, int pair_ = 0) { nM = nM_; nN = nN_; nwg = nM * nN; G = G_; c = c_; pair = pair_; }
    DI bool next(int i, Unit& u) const {
        const long L = (long)(pair ? (i >> 1) : i) * G + c; if (L >= nwg) return false;
        u.kh = pair ? (i & 1) : 0;
        const int wgid = xcd_remap((int)L, nwg);
        const int nig = WGM * nN, gid = wgid / nig, fm = gid * WGM, gsz = (nM - fm) < WGM ? (nM - fm) : WGM;
        u.pm = fm + ((wgid % nig) % gsz); u.pn = (wgid % nig) / gsz; return true;
    }
};
struct GroupOrder {
    int gm, gn, nwg, G, c;
    DI void init(int ngrp, int gm_, int gn_, int G_, int c_) { gm = gm_; gn = gn_; nwg = ngrp * gm * gn; G = G_; c = c_; }
    DI bool next(int i, Unit& u) const {
        const long L = (long)i * G + c; if (L >= nwg) return false;
        u.kh = 0;
        const int wgid = xcd_remap((int)L, nwg);
        const int per = gm * gn, g = wgid / per, r = wgid % per;
        u.pm = g * gm + (r % gm); u.pn = g * gn + (r / gm); return true;
    }
};

typedef f32x4 Acc[2][2][4][2];

template <class Epi, class Sched>
DI void gemm_phase(LAS unsigned char* lds, const Gemm g, const Sched& S, const Epi& E) {
    const int tid = threadIdx.x, wid = __builtin_amdgcn_readfirstlane(tid >> 6), lane = tid & 63, wr = wid >> 2, wc = wid & 3, fr = lane & 15, fq = lane >> 4;
    const int K = g.K, nt = K / BK;
    unsigned voffA[2], voffB[2];
#pragma unroll
    for (int i = 0; i < 2; ++i) { int R, C; stage_rc(tid * 16 + i * 8192, R, C); const int Rb = (R & ~31) + perm32(R & 31);
        voffA[i] = (unsigned)(R * g.lda + (C >> 4) * g.ksubA + (C & 15)) * 2u; voffB[i] = (unsigned)(Rb * g.ldb + C) * 2u; }
    const size_t kstepA = (size_t)g.ksubA * 8, kstepB = (size_t)(BK * 2);
    const size_t hstepA = (size_t)HALF * g.lda * 2, hstepB = (size_t)HALF * g.ldb * 2;
    const size_t tstepA = 2 * hstepA, tstepB = 2 * hstepB;
    const unsigned ldsw = (unsigned)wid * 1024u;
    const int aoff = lds_byte(wr * 64 + fr, fq * 8), boff = lds_byte(wc * 32 + fr, fq * 8);
#define PG8_SA(b, h) (((b) * 2 + (h)) * HTB)
#define PG8_SB(b, h) ((4 + (b) * 2 + (h)) * HTB)
#define PG8_STAGE(bufoff, gbase, voff) do { _Pragma("unroll") for (int _i = 0; _i < 2; ++_i) \
        __builtin_amdgcn_global_load_lds((const unsigned*)((const char*)(gbase) + (voff)[_i]), (LAS unsigned*)(lds + (bufoff) + ldsw + _i * 8192), 16, 0, 0); } while (0)
#define PG8_LDA(dst, b, h) do { _Pragma("unroll") for (int m = 0; m < 4; ++m) _Pragma("unroll") for (int k = 0; k < 2; ++k) dst[m][k] = *(const LAS bf16x8*)(lds + PG8_SA(b, h) + aoff + m * 2048 + k * 1024); } while (0)
#define PG8_LDB(dst, b, h) do { _Pragma("unroll") for (int n = 0; n < 2; ++n) _Pragma("unroll") for (int k = 0; k < 2; ++k) dst[n][k] = *(const LAS bf16x8*)(lds + PG8_SB(b, h) + boff + n * 2048 + k * 1024); } while (0)
#define PG8_MMA(ai, bj, At, Bt) do { __builtin_amdgcn_s_setprio(1); _Pragma("unroll") for (int m = 0; m < 4; ++m) _Pragma("unroll") for (int n = 0; n < 2; ++n) _Pragma("unroll") for (int k = 0; k < 2; ++k) \
        acc[ai][bj][m][n] = __builtin_amdgcn_mfma_f32_16x16x32_bf16(Bt[n][k], At[m][k], acc[ai][bj][m][n], 0, 0, 0); __builtin_amdgcn_s_setprio(0); } while (0)
#define PG8_WAIT_V(n) asm volatile("s_waitcnt vmcnt(" #n ")" ::: "memory")
#define PG8_WAIT_L(n) asm volatile("s_waitcnt lgkmcnt(" #n ")" ::: "memory")
#define PG8_BAR __builtin_amdgcn_s_barrier()
#define PG8_SCHED __builtin_amdgcn_sched_barrier(0)
    Unit cur, nxt; int ui = 0;
    if (!S.next(0, cur)) return;
    Acc acc;
#pragma unroll
    for (int a = 0; a < 2; ++a)
#pragma unroll
        for (int b = 0; b < 2; ++b)
#pragma unroll
            for (int m = 0; m < 4; ++m)
#pragma unroll
                for (int n = 0; n < 2; ++n) acc[a][b][m][n] = (f32x4){0.f, 0.f, 0.f, 0.f};
    bf16x8 At[4][2], B0[2][2], B1[2][2];
    const char* cA = (const char*)g.A + (size_t)cur.pm * tstepA + (size_t)cur.kh * g.kofsA; const char* cB = (const char*)g.Bt + (size_t)cur.pn * tstepB + (size_t)cur.kh * g.kofsB;
    PG8_STAGE(PG8_SB(0, 0), cB, voffB); PG8_STAGE(PG8_SB(0, 1), cB + hstepB, voffB); PG8_STAGE(PG8_SA(0, 0), cA, voffA); PG8_STAGE(PG8_SA(0, 1), cA + hstepA, voffA);
    if (wr == 1) PG8_BAR;
    PG8_WAIT_V(2); PG8_BAR;
    PG8_STAGE(PG8_SB(1, 0), cB + kstepB, voffB); PG8_STAGE(PG8_SA(1, 0), cA + kstepA, voffA); PG8_STAGE(PG8_SB(1, 1), cB + hstepB + kstepB, voffB);
    PG8_WAIT_V(6); PG8_BAR;
    for (;;) {
        const bool has_next = S.next(ui + 1, nxt);
        const char* nA = has_next ? (const char*)g.A + (size_t)nxt.pm * tstepA + (size_t)nxt.kh * g.kofsA : cA; const char* nB = has_next ? (const char*)g.Bt + (size_t)nxt.pn * tstepB + (size_t)nxt.kh * g.kofsB : cB;
        for (int t = 0; t < nt; t += 2) {
            const bool last = (t == nt - 2);
            const char* a1 = cA + (size_t)(t + 1) * kstepA;
            const char* a2 = last ? nA : cA + (size_t)(t + 2) * kstepA; const char* b2 = last ? nB : cB + (size_t)(t + 2) * kstepB;
            const char* a3 = a2 + kstepA; const char* b3 = b2 + kstepB;
            PG8_LDB(B0, 0, 0); PG8_LDB(B1, 0, 1); PG8_SCHED; PG8_LDA(At, 0, 0); PG8_STAGE(PG8_SA(1, 1), a1 + hstepA, voffA);
            PG8_WAIT_V(8); PG8_WAIT_L(0); PG8_BAR; PG8_MMA(0, 0, At, B0); PG8_MMA(0, 1, At, B1); PG8_BAR; PG8_SCHED;
            PG8_LDA(At, 0, 1); PG8_STAGE(PG8_SB(0, 0), b2, voffB); PG8_STAGE(PG8_SB(0, 1), b2 + hstepB, voffB); PG8_STAGE(PG8_SA(0, 0), a2, voffA);
            PG8_WAIT_V(8); PG8_WAIT_L(0); PG8_BAR; PG8_MMA(1, 0, At, B0); PG8_MMA(1, 1, At, B1); PG8_BAR; PG8_SCHED;
            PG8_LDB(B0, 1, 0); PG8_LDB(B1, 1, 1); PG8_SCHED; PG8_LDA(At, 1, 0); PG8_STAGE(PG8_SA(0, 1), a2 + hstepA, voffA);
            PG8_WAIT_V(8); PG8_WAIT_L(0); PG8_BAR; PG8_MMA(0, 0, At, B0); PG8_MMA(0, 1, At, B1); PG8_BAR; PG8_SCHED;
            PG8_LDA(At, 1, 1); PG8_STAGE(PG8_SB(1, 0), b3, voffB); PG8_STAGE(PG8_SB(1, 1), b3 + hstepB, voffB); PG8_STAGE(PG8_SA(1, 0), a3, voffA);
            PG8_WAIT_V(8); PG8_WAIT_L(0); PG8_BAR; PG8_MMA(1, 0, At, B0); PG8_MMA(1, 1, At, B1); PG8_BAR; PG8_SCHED;
        }
        if (wr == 0) PG8_BAR;
        E(acc, cur, wr, wc, fr, fq);
        if (!has_next) break;
        if (!(Epi::MID > 0 && cur.kh == 0))
#pragma unroll
        for (int a = 0; a < 2; ++a)
#pragma unroll
            for (int b = 0; b < 2; ++b)
#pragma unroll
                for (int m = 0; m < 4; ++m)
#pragma unroll
                    for (int n = 0; n < 2; ++n) acc[a][b][m][n] = (f32x4){0.f, 0.f, 0.f, 0.f};
        cur = nxt; cA = nA; cB = nB; ++ui;
        if (wr == 1) PG8_BAR;
    }
    PG8_WAIT_V(0);
    PG8_BAR;
#undef PG8_SA
#undef PG8_SB
#undef PG8_STAGE
#undef PG8_LDA
#undef PG8_LDB
#undef PG8_MMA
#undef PG8_WAIT_V
#undef PG8_WAIT_L
#undef PG8_BAR
#undef PG8_SCHED
}
}
using pg8::Acc; using pg8::Unit;

struct EpiIn {
    static constexpr int MID = 0;
    bf16_t *Q, *Kb, *Vb, *ucat, *Ga, *Gs; const float* rope;
    DI void operator()(Acc& acc, const Unit& u, int wr, int wc, int fr, int fq) const {
        const int pn = u.pn, row0 = u.pm * 256 + wr * 64 + fr;
#pragma unroll
        for (int ai = 0; ai < 2; ++ai) {
            f32x4 rc[4][4];
            if (pn < 3 && (wc & 1) == 0 && fq < 2) {
#pragma unroll
                for (int m = 0; m < 4; ++m) { const float* cs = rope + (size_t)((row0 + ai * 128 + m * 16) & (SEQ - 1)) * 16;
                    rc[m][0] = *(const f32x4*)cs; rc[m][1] = *(const f32x4*)(cs + 4); rc[m][2] = *(const f32x4*)(cs + 8); rc[m][3] = *(const f32x4*)(cs + 12); }
            } else {
#pragma unroll
                for (int m = 0; m < 4; ++m) { rc[m][0] = rc[m][1] = rc[m][2] = rc[m][3] = (f32x4){0.f, 0.f, 0.f, 0.f}; }
            }
            __builtin_amdgcn_sched_barrier(0);
#pragma unroll
            for (int m = 0; m < 4; ++m) {
                const int row = row0 + ai * 128 + m * 16;
#pragma unroll
                for (int bj = 0; bj < 2; ++bj) {
                    f32x4 v0 = acc[ai][bj][m][0], v1 = acc[ai][bj][m][1];
                    const int col = pn * 256 + bj * 128 + wc * 32 + 8 * fq;
                    if (pn < 3) {
                        const bool is_v = (pn == 2 && bj == 1);
                        if (!is_v && (wc & 1) == 0) {
                            f32x4 p0, p1;
#pragma unroll
                            for (int j = 0; j < 4; ++j) { p0[j] = __shfl_xor(v0[j], 16); p1[j] = __shfl_xor(v1[j], 16); }
                            if (fq < 2) {
                                const f32x4 c0 = rc[m][0], c1 = rc[m][1], s0 = rc[m][2], s1 = rc[m][3];
                                const float sg = fq == 0 ? -1.f : 1.f;
                                v0 = v0 * c0 + sg * (p0 * s0); v1 = v1 * c1 + sg * (p1 * s1);
                            }
                        }
                        if (pn < 2) { v0 = v0 * 0.18033688f; v1 = v1 * 0.18033688f;     *(u32x4*)(Q + (size_t)row * 512 + col) = pack8(v0, v1); }
                        else if (bj == 0) *(u32x4*)(Kb + (size_t)row * 128 + (col - 512)) = pack8(v0, v1);
                        else *(u32x4*)(Vb + (size_t)row * 128 + (col - 640)) = pack8(v0, v1);
                    } else if (pn < 5) {
                        const int cu = col - 768, gi = cu >> 4, hh0 = cu & 15;
                        *(u32x4*)(ucat + ((size_t)gi * NROW + (row >> 5)) * UCK + (row & 31) * 16 + hh0) = pack8(v0, v1);
                    } else if (bj == 0) {
                        const f32x4 a0 = acc[ai][0][m][0], a1 = acc[ai][0][m][1], b0 = acc[ai][1][m][0], b1 = acc[ai][1][m][1];
                        f32x4 r0, r1, g0, g1;
#pragma unroll
                        for (int j = 0; j < 4; ++j) {
                            const float pa0 = 1.0f + __expf(-a0[j]), pa1 = 1.0f + __expf(-a1[j]), pb0 = 1.0f + __expf(-b0[j]), pb1 = 1.0f + __expf(-b1[j]);
                            const float i0 = __builtin_amdgcn_rcpf(pa0 * pb0), i1 = __builtin_amdgcn_rcpf(pa1 * pb1);
                            g0[j] = pa0 * i0; g1[j] = pa1 * i1;
                            r0[j] = pb0 * pb0 * i0; r1[j] = pb1 * pb1 * i1;
                        }
                        const size_t o = (size_t)row * DM + (pn - 5) * 128 + wc * 32 + 8 * fq;
                        *(u32x4*)(Ga + o) = pack8(r0, r1); *(u32x4*)(Gs + o) = pack8(g0, g1);
                    }
                }
            }
        }
    }
};
struct EpiF {
    static constexpr int MID = 0;
    float* F;
    DI void operator()(Acc& acc, const Unit& u, int wr, int wc, int fr, int fq) const {
        const int row0 = u.pm * 256 + wr * 64 + fr;
#pragma unroll
        for (int ai = 0; ai < 2; ++ai)
#pragma unroll
            for (int m = 0; m < 4; ++m)
#pragma unroll
                for (int bj = 0; bj < 2; ++bj) {
                    float* p = F + (size_t)(row0 + ai * 128 + m * 16) * 256 + bj * 128 + wc * 32 + 8 * fq;
                    *(f32x4*)p = acc[ai][bj][m][0]; *(f32x4*)(p + 4) = acc[ai][bj][m][1];
                }
    }
};
struct EpiY {
    static constexpr int MID = 0;
    bf16_t* yg;
    DI void operator()(Acc& acc, const Unit& u, int wr, int wc, int fr, int fq) const {
        const int row0 = u.pm * 256 + wr * 64 + fr, colt = (u.pn & 1) * 256 + wc * 32 + 8 * fq;
#pragma unroll
        for (int ai = 0; ai < 2; ++ai)
#pragma unroll
            for (int m = 0; m < 4; ++m)
#pragma unroll
                for (int bj = 0; bj < 2; ++bj) {
                    f32x4 v0 = acc[ai][bj][m][0], v1 = acc[ai][bj][m][1];
#pragma unroll
                    for (int j = 0; j < 4; ++j) { v0[j] = gelu_tanh(v0[j]); v1[j] = gelu_tanh(v1[j]); }
                    *(u32x4*)(yg + (size_t)(row0 + ai * 128 + m * 16) * 512 + colt + bj * 128) = pack8(v0, v1);
                }
    }
};
struct EpiGlu {
    static constexpr int MID = 0;
    const bf16_t* yg; bf16_t* AS;
    DI void operator()(Acc& acc, const Unit& u, int wr, int wc, int fr, int fq) const {
        const int row0 = u.pm * 256 + wr * 64 + fr;
        u32x4 yv[2][4][2];
#pragma unroll
        for (int ai = 0; ai < 2; ++ai)
#pragma unroll
            for (int m = 0; m < 4; ++m)
#pragma unroll
                for (int bj = 0; bj < 2; ++bj) { const int col = u.pn * 256 + bj * 128 + wc * 32 + 8 * fq;
                    yv[ai][m][bj] = *(const u32x4*)(yg + (size_t)(col >> 4) * (NTOK * 16) + (size_t)(row0 + ai * 128 + m * 16) * 16 + (col & 15)); }
        __builtin_amdgcn_sched_barrier(0);
#pragma unroll
        for (int ai = 0; ai < 2; ++ai)
#pragma unroll
            for (int m = 0; m < 4; ++m) {
                const int row = row0 + ai * 128 + m * 16;
#pragma unroll
                for (int bj = 0; bj < 2; ++bj) {
                    const int col = u.pn * 256 + bj * 128 + wc * 32 + 8 * fq;
                    const u32x4 yw = yv[ai][m][bj];
                    f32x4 y0, y1; unpack8(yw, y0, y1);
                    f32x4 v0 = acc[ai][bj][m][0], v1 = acc[ai][bj][m][1];
#pragma unroll
                    for (int j = 0; j < 4; ++j) { v0[j] = y0[j] * sigmoid_f(v0[j]); v1[j] = y1[j] * sigmoid_f(v1[j]); }
                    *(u32x4*)(AS + (size_t)row * DM + 512 + col) = pack8(v0, v1);
                }
            }
    }
};
struct EpiMerge {
    static constexpr int MID = 8;
    const bf16_t *Ga, *Gs; bf16_t* Mg;
    DI void mid(Acc& acc, const Unit& u, int wr, int wc, int fr, int fq) const {
        const char* base = (const char*)Ga + ((size_t)u.pm * 256 * DM + (size_t)u.pn * 256) * 2;
        const unsigned lo = (unsigned)((wr * 64 + fr) * DM + wc * 32 + 8 * fq) * 2u;
        u32x4 w[2][4][2];
#pragma unroll
        for (int ai = 0; ai < 2; ++ai)
#pragma unroll
            for (int m = 0; m < 4; ++m)
#pragma unroll
                for (int bj = 0; bj < 2; ++bj) w[ai][m][bj] = *(const u32x4*)(base + (size_t)((ai * 128 + m * 16) * DM + bj * 128) * 2 + lo);
        __builtin_amdgcn_sched_barrier(0);
#pragma unroll
        for (int ai = 0; ai < 2; ++ai)
#pragma unroll
            for (int m = 0; m < 4; ++m)
#pragma unroll
                for (int bj = 0; bj < 2; ++bj) { f32x4 a0, a1; unpack8(w[ai][m][bj], a0, a1); acc[ai][bj][m][0] *= a0; acc[ai][bj][m][1] *= a1; }
    }
    DI void operator()(Acc& acc, const Unit& u, int wr, int wc, int fr, int fq) const {
        if (u.kh == 0) { mid(acc, u, wr, wc, fr, fq); return; }
        const int row0 = u.pm * 256 + wr * 64 + fr, col0 = u.pn * 256 + wc * 32 + 8 * fq;
        u32x4 w[2][4][2];
#pragma unroll
        for (int ai = 0; ai < 2; ++ai)
#pragma unroll
            for (int m = 0; m < 4; ++m)
#pragma unroll
                for (int bj = 0; bj < 2; ++bj) w[ai][m][bj] = *(const u32x4*)(Gs + (size_t)(row0 + ai * 128 + m * 16) * DM + col0 + bj * 128);
        __builtin_amdgcn_sched_barrier(0);
#pragma unroll
        for (int ai = 0; ai < 2; ++ai)
#pragma unroll
            for (int m = 0; m < 4; ++m)
#pragma unroll
                for (int bj = 0; bj < 2; ++bj) {
                    const size_t o = (size_t)(row0 + ai * 128 + m * 16) * DM + col0 + bj * 128;
                    f32x4 s0, s1; unpack8(w[ai][m][bj], s0, s1);
                    f32x4 v0 = acc[ai][bj][m][0], v1 = acc[ai][bj][m][1];
#pragma unroll
                    for (int j = 0; j < 4; ++j) { v0[j] *= fmaxf(s0[j], 1e-30f); v1[j] *= fmaxf(s1[j], 1e-30f); }
                    *(u32x4*)(Mg + o) = pack8(v0, v1);
                }
    }
};
template <bool IN_BF> struct EpiRes {
    static constexpr int MID = 0;
    const float* xi; const bf16_t* xib; bf16_t* xb; float* ssq;
    DI void operator()(Acc& acc, const Unit& u, int wr, int wc, int fr, int fq) const {
        const int row0 = u.pm * 256 + wr * 64 + fr, col0 = u.pn * 256 + wc * 32 + 8 * fq;
#pragma unroll
        for (int ai = 0; ai < 2; ++ai) {
            f32x4 xv[4][2][2];
            if (IN_BF) {
                u32x4 w[4][2];
#pragma unroll
                for (int m = 0; m < 4; ++m)
#pragma unroll
                    for (int bj = 0; bj < 2; ++bj) w[m][bj] = *(const u32x4*)(xib + (size_t)(row0 + ai * 128 + m * 16) * DM + col0 + bj * 128);
                __builtin_amdgcn_sched_barrier(0);
#pragma unroll
                for (int m = 0; m < 4; ++m)
#pragma unroll
                    for (int bj = 0; bj < 2; ++bj) unpack8(w[m][bj], xv[m][bj][0], xv[m][bj][1]);
            } else {
#pragma unroll
                for (int m = 0; m < 4; ++m)
#pragma unroll
                    for (int bj = 0; bj < 2; ++bj) { const float* p = xi + (size_t)(row0 + ai * 128 + m * 16) * DM + col0 + bj * 128; xv[m][bj][0] = *(const f32x4*)p; xv[m][bj][1] = *(const f32x4*)(p + 4); }
                __builtin_amdgcn_sched_barrier(0);
            }
#pragma unroll
            for (int m = 0; m < 4; ++m) {
                const int row = row0 + ai * 128 + m * 16; float ss = 0.f;
#pragma unroll
                for (int bj = 0; bj < 2; ++bj) {
                    const size_t o = (size_t)row * DM + col0 + bj * 128;
                    const f32x4 v0 = xv[m][bj][0] + acc[ai][bj][m][0], v1 = xv[m][bj][1] + acc[ai][bj][m][1];
                    *(u32x4*)(xb + o) = pack8(v0, v1);
                    ss += (v0[0] * v0[0] + v0[1] * v0[1]) + (v0[2] * v0[2] + v0[3] * v0[3]) + (v1[0] * v1[0] + v1[1] * v1[1]) + (v1[2] * v1[2] + v1[3] * v1[3]);
                }
                ss += __shfl_xor(ss, 16); ss = xhalf_sum(ss);
                if (fq == 0) ssq[(size_t)row * 16 + u.pn * 4 + wc] = ss;
            }
        }
    }
};
struct EpiFfn1 {
    static constexpr int MID = 0;
    const float* ssq; bf16_t* hmid;
    DI void operator()(Acc& acc, const Unit& u, int wr, int wc, int fr, int fq) const {
        const int row0 = u.pm * 256 + wr * 64 + fr, col0 = u.pn * 128 + wc * 32 + 8 * fq;
        f32x4 qv[2][4];
#pragma unroll
        for (int ai = 0; ai < 2; ++ai)
#pragma unroll
            for (int m = 0; m < 4; ++m) qv[ai][m] = *((const f32x4*)(ssq + (size_t)(row0 + ai * 128 + m * 16) * 16) + fq);
        __builtin_amdgcn_sched_barrier(0);
#pragma unroll
        for (int ai = 0; ai < 2; ++ai)
#pragma unroll
            for (int m = 0; m < 4; ++m) {
                const int row = row0 + ai * 128 + m * 16;
                float tot = (qv[ai][m][0] + qv[ai][m][1]) + (qv[ai][m][2] + qv[ai][m][3]);
                tot += __shfl_xor(tot, 16); tot = xhalf_sum(tot);
                const float rs = 1.0f / sqrtf(tot * (1.0f / DM) + RMS_EPS);
                f32x4 v0, v1;
#pragma unroll
                for (int j = 0; j < 4; ++j) {
                    const float g0 = rs * acc[ai][0][m][0][j], g1 = rs * acc[ai][0][m][1][j];
                    v0[j] = g0 * sigmoid_f(g0) * (rs * acc[ai][1][m][0][j]); v1[j] = g1 * sigmoid_f(g1) * (rs * acc[ai][1][m][1][j]);
                }
                *(u32x4*)(hmid + (size_t)row * DFF + col0) = pack8(v0, v1);
            }
    }
};

DI void tr_item(const float* W, int K, int N, bf16_t* WT, int ldt, int koff, int mode, const float* scale, LAS float* scr, int item, int lane) {
    const int nblk = N / 32, kb = item / nblk, nb = item % nblk, k0 = 64 * kb, n0 = 32 * nb;
    float wv[32];
#pragma unroll
    for (int i = 0; i < 32; ++i) { const int kk = 2 * i + (lane >> 5); wv[i] = __builtin_nontemporal_load(W + (size_t)(k0 + kk) * N + n0 + (lane & 31)); }
    float sv = 1.0f; if (scale) sv = scale[k0 + lane];
#pragma unroll
    for (int i = 0; i < 32; ++i) { const int kk = 2 * i + (lane >> 5); const float w = wv[i] * __shfl(sv, kk); scr[kk * 33 + (lane & 31)] = w; }
    asm volatile("s_waitcnt lgkmcnt(0)" ::: "memory");
    const int c = lane & 7;
#pragma unroll
    for (int j = 0; j < 4; ++j) { const int n = (lane >> 3) + 8 * j; const LAS float* s = scr + (8 * c) * 33 + n;
        u32x4 o; o.x = pk_bf16(s[0 * 33], s[1 * 33]); o.y = pk_bf16(s[2 * 33], s[3 * 33]); o.z = pk_bf16(s[4 * 33], s[5 * 33]); o.w = pk_bf16(s[6 * 33], s[7 * 33]);
        const int ng = n0 + n; int rowd;
        if (mode == 0) rowd = ng; else if (mode == 3) { if (ng < 1280) rowd = ng; else { const int n2 = ng - 1280, cg2 = n2 & 1023; rowd = 1280 + (cg2 >> 7) * 256 + (n2 >= 1024 ? 128 : 0) + (cg2 & 127); } }
        else rowd = (ng >> 7) * 256 + (mode == 2 ? 128 : 0) + (ng & 127);
        *(u32x4*)(WT + (size_t)rowd * ldt + koff + k0 + 8 * c) = o; }
    asm volatile("s_waitcnt lgkmcnt(0)" ::: "memory");
}

DI void ssm_tables(LAS unsigned char* lds, int g, int hf, const float* lam_re, const float* lam_im, const float* log_dt, const float* b_re, const float* b_im,
                   const float* c_re, const float* c_im, const float* dvec, bf16_t* Win, bf16_t* Bt2, float* lamT) {
    LAS float* pw = (LAS float*)lds;
    LAS float* bb = pw + 8448;
    LAS float* cc = bb + 4096;
    LAS float* Kt = cc + 2048;
    LAS float* coef = Kt + 8192;
    const int tid = threadIdx.x;
    if (tid < 128) {
        const int dir = tid >> 6, p = tid & 63; const int gi = (dir * 32 + g) * 64 + p;
        const float lr = lam_re[gi], li = lam_im[gi], dt = expf(log_dt[dir * 32 + g]);
        const float mag = expf(lr * dt); float sn, cs; sincosf(li * dt, &sn, &cs);
        const float ar = mag * cs, ai = mag * sn;
        { const float nr = ar - 1.0f, ni = ai, den = lr * lr + li * li;
          coef[(dir * 64 + p) * 2] = (nr * lr + ni * li) / den; coef[(dir * 64 + p) * 2 + 1] = (ni * lr - nr * li) / den; }
        float wr_ = 1.f, wi_ = 0.f;
        for (int tau = 0; tau <= 32; ++tau) {
            pw[((dir * 64 + p) * 33 + tau) * 2] = wr_; pw[((dir * 64 + p) * 33 + tau) * 2 + 1] = wi_;
            if (tau == 32 && hf == 0) { lamT[((g * 2 + dir) * 64 + p) * 2] = wr_; lamT[((g * 2 + dir) * 64 + p) * 2 + 1] = wi_; }
            const float nr = wr_ * ar - wi_ * ai, ni = wr_ * ai + wi_ * ar; wr_ = nr; wi_ = ni;
        }
    }
    __syncthreads();
    for (int idx = tid; idx < 2048; idx += 512) {
        const int dir = idx >> 10, p = (idx >> 4) & 63, h = idx & 15; const int gi = ((dir * 32 + g) * 64 + p) * 16 + h;
        const float br = b_re[gi], bi = b_im[gi], cr = coef[(dir * 64 + p) * 2], ci = coef[(dir * 64 + p) * 2 + 1];
        bb[idx * 2] = cr * br - ci * bi; bb[idx * 2 + 1] = cr * bi + ci * br;
    }
    for (int idx = tid; idx < 1024; idx += 512) {
        const int hh = idx >> 6, p = idx & 63;
        cc[(p * 16 + hh) * 2] = c_re[g * 1024 + idx]; cc[(p * 16 + hh) * 2 + 1] = c_im[g * 1024 + idx];
    }
    __syncthreads();
    {
        const int dir = tid >> 8, tau = (tid >> 3) & 31, hl = tid & 7, hh = 8 * hf + hl;
        float a[16];
#pragma unroll
        for (int h = 0; h < 16; ++h) a[h] = 0.f;
        for (int p = 0; p < 64; ++p) {
            const f32x2 cv = *(const LAS f32x2*)(cc + (p * 16 + hh) * 2), pv = *(const LAS f32x2*)(pw + ((dir * 64 + p) * 33 + tau) * 2);
            const float zr = cv[0] * pv[0] - cv[1] * pv[1], zi = cv[0] * pv[1] + cv[1] * pv[0];
            const LAS f32x4* bp = (const LAS f32x4*)(bb + (dir * 64 + p) * 32);
#pragma unroll
            for (int h2 = 0; h2 < 8; ++h2) { const f32x4 bv = bp[h2]; a[2 * h2] += zr * bv[0] - zi * bv[1]; a[2 * h2 + 1] += zr * bv[2] - zi * bv[3]; }
        }
#pragma unroll
        for (int h = 0; h < 16; ++h) Kt[((dir * 32 + tau) * 8 + hl) * 16 + h] = a[h];
    }
    __syncthreads();
    for (int idx = tid; idx < 8192; idx += 512) {
        const int s = idx & 31, rl = idx >> 5, t = rl >> 3, hl = rl & 7, hh = 8 * hf + hl, row = t * 16 + hh;
        float v[16];
        if (t > s) {
#pragma unroll
            for (int h = 0; h < 16; ++h) v[h] = Kt[(((t - s)) * 8 + hl) * 16 + h];
        } else if (t < s) {
#pragma unroll
            for (int h = 0; h < 16; ++h) v[h] = Kt[((32 + (s - t)) * 8 + hl) * 16 + h];
        } else {
            const float dd = dvec[g * 16 + hh];
#pragma unroll
            for (int h = 0; h < 16; ++h) v[h] = Kt[(hl) * 16 + h] + Kt[((32) * 8 + hl) * 16 + h] + (h == hh ? dd : 0.f);
        }
        u32x4 o0, o1;
        o0.x = pk_bf16(v[0], v[1]); o0.y = pk_bf16(v[2], v[3]); o0.z = pk_bf16(v[4], v[5]); o0.w = pk_bf16(v[6], v[7]);
        o1.x = pk_bf16(v[8], v[9]); o1.y = pk_bf16(v[10], v[11]); o1.z = pk_bf16(v[12], v[13]); o1.w = pk_bf16(v[14], v[15]);
        bf16_t* d = Bt2 + ((size_t)(g * 512 + row)) * UCK + s * 16;
        *(u32x4*)d = o0; *(u32x4*)(d + 8) = o1;
    }
    for (int idx = tid; idx < 256 * 32; idx += 512) {
        const int c8 = idx & 31, rl = idx >> 5, t = rl >> 3, hl = rl & 7, hh = 8 * hf + hl, row = t * 16 + hh;
        const int col = c8 * 8, dir = col >> 7, ri = (col >> 6) & 1, p0 = col & 63;
        const int e = dir ? (CH - t) : (t + 1);
        float v[8];
#pragma unroll
        for (int q = 0; q < 8; ++q) {
            const f32x2 cv = *(const LAS f32x2*)(cc + ((p0 + q) * 16 + hh) * 2), pv = *(const LAS f32x2*)(pw + ((dir * 64 + p0 + q) * 33 + e) * 2);
            v[q] = ri ? -(cv[0] * pv[1] + cv[1] * pv[0]) : (cv[0] * pv[0] - cv[1] * pv[1]);
        }
        u32x4 o; o.x = pk_bf16(v[0], v[1]); o.y = pk_bf16(v[2], v[3]); o.z = pk_bf16(v[4], v[5]); o.w = pk_bf16(v[6], v[7]);
        *(u32x4*)(Bt2 + ((size_t)(g * 512 + row)) * UCK + 512 + col) = o;
    }
    for (int idx = tid; idx < 4096; idx += 512) {
        const int s = idx & 31, cl = idx >> 5, dir = cl >> 6, ri = (cl >> 5) & 1, p = 32 * hf + (cl & 31), comp = dir * 128 + ri * 64 + p;
        const int e = dir ? s : (CH - 1 - s);
        const float pr = pw[((dir * 64 + p) * 33 + e) * 2], pi = pw[((dir * 64 + p) * 33 + e) * 2 + 1];
        const LAS float* bp = bb + (dir * 64 + p) * 32;
        float v[16];
#pragma unroll
        for (int h = 0; h < 16; ++h) { const float br = bp[2 * h], bi = bp[2 * h + 1]; v[h] = ri ? (pr * bi + pi * br) : (pr * br - pi * bi); }
        u32x4 o0, o1;
        o0.x = pk_bf16(v[0], v[1]); o0.y = pk_bf16(v[2], v[3]); o0.z = pk_bf16(v[4], v[5]); o0.w = pk_bf16(v[6], v[7]);
        o1.x = pk_bf16(v[8], v[9]); o1.y = pk_bf16(v[10], v[11]); o1.z = pk_bf16(v[12], v[13]); o1.w = pk_bf16(v[14], v[15]);
        bf16_t* d = Win + ((size_t)(g * 256 + comp)) * 512 + s * 16;
        *(u32x4*)d = o0; *(u32x4*)(d + 8) = o1;
    }
    __syncthreads();
}

#define MFMA32(a, b, c) __builtin_amdgcn_mfma_f32_32x32x16_bf16((a), (b), (c), 0, 0, 0)
DI void attn_phase(LAS unsigned char* lds, const bf16_t* Q, const bf16_t* Kb, const bf16_t* Vb, bf16_t* AS, const float* sink, int u0, int u1) {
    constexpr int KS = 72, VS = 324, NKEY = 320;
    const int tid = threadIdx.x, lane = tid & 63, wid = __builtin_amdgcn_readfirstlane(tid >> 6), r32 = lane & 31, hi = lane >> 5;
    LAS bf16_t* Kl = (LAS bf16_t*)lds; LAS bf16_t* Vl = (LAS bf16_t*)(lds + NKEY * KS * 2);
    u32x4 kreg[5], vreg[5]; bf16x8 qreg[4];
#define ATT_PREFETCH(un) do { const int kvh_ = (un) & 1, qb_ = ((un) >> 1) & 63, b_ = (un) >> 7; _Pragma("unroll") for (int it = 0; it < 5; ++it) { const int idx = tid + 512 * it, key = idx >> 3, piece = idx & 7, kpos = qb_ * 64 - 128 + key; \
        kreg[it] = (u32x4){0u, 0u, 0u, 0u}; vreg[it] = (u32x4){0u, 0u, 0u, 0u}; \
        if (kpos >= 0 && kpos < SEQ) { const size_t base = (size_t)(b_ * SEQ + kpos) * 128 + kvh_ * 64 + piece * 8; kreg[it] = *(const u32x4*)(Kb + base); vreg[it] = *(const u32x4*)(Vb + base); } } \
        { const size_t qrow_ = (size_t)(b_ * SEQ + qb_ * 64 + (wid & 1) * 32 + r32); const int hq_ = kvh_ * 4 + (wid >> 1); \
          _Pragma("unroll") for (int ds = 0; ds < 4; ++ds) qreg[ds] = *(const bf16x8*)(Q + qrow_ * 512 + hq_ * 64 + ds * 16 + hi * 8); } } while (0)
    if (u0 < u1) ATT_PREFETCH(u0);
    for (int unit = u0; unit < u1; ++unit) {
        const int kvh = unit & 1, qb = (unit >> 1) & 63, b = unit >> 7;
        const int q0 = qb * 64, key0 = q0 - 128;
        __syncthreads();
#pragma unroll
        for (int it = 0; it < 5; ++it) {
            const int idx = tid + 512 * it, key = idx >> 3, piece = idx & 7;
            const u32x4 kv = kreg[it], vv = vreg[it];
            *(LAS u32x4*)(Kl + key * KS + piece * 8) = kv;
            LAS bf16_t* vp = Vl + (piece * 8) * VS + key;
            vp[0 * VS] = (bf16_t)(vv.x & 0xffffu); vp[1 * VS] = (bf16_t)(vv.x >> 16); vp[2 * VS] = (bf16_t)(vv.y & 0xffffu); vp[3 * VS] = (bf16_t)(vv.y >> 16);
            vp[4 * VS] = (bf16_t)(vv.z & 0xffffu); vp[5 * VS] = (bf16_t)(vv.z >> 16); vp[6 * VS] = (bf16_t)(vv.w & 0xffffu); vp[7 * VS] = (bf16_t)(vv.w >> 16);
        }
        __syncthreads();
        bf16x8 qf[4];
#pragma unroll
        for (int ds = 0; ds < 4; ++ds) qf[ds] = qreg[ds];
        if (unit + 1 < u1) ATT_PREFETCH(unit + 1);
        const int hq = kvh * 4 + (wid >> 1), qh = wid & 1;
        const int qmin = q0 + qh * 32, qmax = qmin + 31;
        const int qpos = qmin + r32; const size_t qrow = (size_t)(b * SEQ + qpos);
        float mrun = sink[hq] * 1.44269504f, lrun = 1.0f;
        f32x16 o0, o1;
#pragma unroll
        for (int r = 0; r < 16; ++r) { o0[r] = 0.f; o1[r] = 0.f; }
        for (int kt = 0; kt < 5; ++kt) {
            f32x16 s0, s1;
            const int ks0 = key0 + kt * 64, ks1 = ks0 + 32;
            const int st0 = (ks0 + 31 < qmin - 128 || ks0 > qmax + 128 || ks0 + 31 < 0 || ks0 >= SEQ) ? 0 : ((ks0 >= qmax - 128 && ks0 + 31 <= qmin + 128 && ks0 >= 0 && ks0 + 31 < SEQ) ? 1 : 2);
            const int st1 = (ks1 + 31 < qmin - 128 || ks1 > qmax + 128 || ks1 + 31 < 0 || ks1 >= SEQ) ? 0 : ((ks1 >= qmax - 128 && ks1 + 31 <= qmin + 128 && ks1 >= 0 && ks1 + 31 < SEQ) ? 1 : 2);
            float mx = mrun;
            bf16x8 kfa[4], kfb[4]; u32x2 vlo[4][2], vhi[4][2];
#pragma unroll
            for (int ds = 0; ds < 4; ++ds) { kfa[ds] = *(const LAS bf16x8*)(Kl + (kt * 64 + r32) * KS + ds * 16 + hi * 8); kfb[ds] = *(const LAS bf16x8*)(Kl + (kt * 64 + 32 + r32) * KS + ds * 16 + hi * 8); }
#pragma unroll
            for (int j = 0; j < 4; ++j) { const int kk = kt * 64 + (j >> 1) * 32 + (j & 1) * 16 + 4 * hi;
                vlo[j][0] = *(const LAS u32x2*)(Vl + (r32) * VS + kk); vhi[j][0] = *(const LAS u32x2*)(Vl + (r32) * VS + kk + 8);
                vlo[j][1] = *(const LAS u32x2*)(Vl + (32 + r32) * VS + kk); vhi[j][1] = *(const LAS u32x2*)(Vl + (32 + r32) * VS + kk + 8); }
            __builtin_amdgcn_sched_barrier(0);
#define ATT_SUB(sv, stv, kfx) \
            if (stv == 0) { _Pragma("unroll") for (int r = 0; r < 16; ++r) sv[r] = -1e30f; } \
            else { \
                _Pragma("unroll") for (int r = 0; r < 16; ++r) sv[r] = 0.f; \
                _Pragma("unroll") for (int ds = 0; ds < 4; ++ds) sv = MFMA32(kfx[ds], qf[ds], sv); \
                if (stv == 2) { const int kb_ = key0 + kt * 64 + ((&kfx[0] == &kfb[0]) ? 32 : 0) + 4 * hi; \
                    _Pragma("unroll") for (int r = 0; r < 16; ++r) { const int kp = kb_ + (r & 3) + 8 * (r >> 2); const int d = qpos - kp; \
                        const bool ok = (d <= 128) && (d >= -128) && (kp >= 0) && (kp < SEQ); sv[r] = ok ? sv[r] : -1e30f; } } \
                _Pragma("unroll") for (int r = 0; r < 16; ++r) mx = fmaxf(mx, sv[r]); \
            }
            ATT_SUB(s0, st0, kfa)
            ATT_SUB(s1, st1, kfb)
#undef ATT_SUB
            mx = xhalf_max(mx);
            const float alpha = __builtin_amdgcn_exp2f(mrun - mx); mrun = mx;
            float sum = 0.f;
#pragma unroll
            for (int r = 0; r < 16; ++r) { s0[r] = __builtin_amdgcn_exp2f(s0[r] - mx); s1[r] = __builtin_amdgcn_exp2f(s1[r] - mx); sum += s0[r] + s1[r]; }
            sum = xhalf_sum(sum);
            lrun = lrun * alpha + sum;
            if (__builtin_amdgcn_ballot_w64(alpha != 1.0f) != 0ull) {
#pragma unroll
                for (int r = 0; r < 16; ++r) { o0[r] *= alpha; o1[r] *= alpha; }
            }
#pragma unroll
            for (int j = 0; j < 4; ++j) {
                if ((j < 2 ? st0 : st1) == 0) continue;
                u32x4 pw4;
                if (j < 2) { pw4.x = pk_bf16(s0[8 * (j & 1) + 0], s0[8 * (j & 1) + 1]); pw4.y = pk_bf16(s0[8 * (j & 1) + 2], s0[8 * (j & 1) + 3]); pw4.z = pk_bf16(s0[8 * (j & 1) + 4], s0[8 * (j & 1) + 5]); pw4.w = pk_bf16(s0[8 * (j & 1) + 6], s0[8 * (j & 1) + 7]); }
                else       { pw4.x = pk_bf16(s1[8 * (j & 1) + 0], s1[8 * (j & 1) + 1]); pw4.y = pk_bf16(s1[8 * (j & 1) + 2], s1[8 * (j & 1) + 3]); pw4.z = pk_bf16(s1[8 * (j & 1) + 4], s1[8 * (j & 1) + 5]); pw4.w = pk_bf16(s1[8 * (j & 1) + 6], s1[8 * (j & 1) + 7]); }
                const bf16x8 pf = __builtin_bit_cast(bf16x8, pw4);
                { const u32x4 vw = {vlo[j][0].x, vlo[j][0].y, vhi[j][0].x, vhi[j][0].y}; o0 = MFMA32(__builtin_bit_cast(bf16x8, vw), pf, o0); }
                { const u32x4 vw = {vlo[j][1].x, vlo[j][1].y, vhi[j][1].x, vhi[j][1].y}; o1 = MFMA32(__builtin_bit_cast(bf16x8, vw), pf, o1); }
            }
        }
        const float inv = 1.0f / lrun;
        bf16_t* op = AS + qrow * DM + hq * 64 + 4 * hi;
#pragma unroll
        for (int g4 = 0; g4 < 4; ++g4) {
            u32x2 w0, w1;
            w0.x = pk_bf16(o0[4 * g4] * inv, o0[4 * g4 + 1] * inv); w0.y = pk_bf16(o0[4 * g4 + 2] * inv, o0[4 * g4 + 3] * inv);
            w1.x = pk_bf16(o1[4 * g4] * inv, o1[4 * g4 + 1] * inv); w1.y = pk_bf16(o1[4 * g4 + 2] * inv, o1[4 * g4 + 3] * inv);
            *(u32x2*)(op + 8 * g4) = w0; *(u32x2*)(op + 32 + 8 * g4) = w1;
        }
    }
    __syncthreads();
}

DI void scan_blk(LAS unsigned char* lds, const float* F, const float* lamT, bf16_t* ucat, int blk) {
    LAS float* E = (LAS float*)lds;
    const int tid = threadIdx.x, seg = tid >> 7, cl = tid & 127;
    {
        const int chain = blk * 128 + cl, p = chain & 63, dir = (chain >> 6) & 1, b = (chain >> 7) & 7, g = chain >> 10;
        const float ar = lamT[((g * 2 + dir) * 64 + p) * 2], ai = lamT[((g * 2 + dir) * 64 + p) * 2 + 1];
        const int comp = dir * 128 + p, rowbase = g * NROW + b * 128;
        float pr[32], pi[32]; float sr = 0.f, si = 0.f;
#pragma unroll
        for (int jj = 0; jj < 32; ++jj) {
            const int j = seg * 32 + jj, ci = dir ? 127 - j : j;
            const float fr = F[(size_t)(rowbase + ci) * 256 + comp], fi = F[(size_t)(rowbase + ci) * 256 + comp + 64];
            pr[jj] = sr; pi[jj] = si;
            const float nr = ar * sr - ai * si + fr, ni = ar * si + ai * sr + fi; sr = nr; si = ni;
        }
        __syncthreads();
        E[(seg * 128 + cl) * 2] = sr; E[(seg * 128 + cl) * 2 + 1] = si;
        __syncthreads();
        float a32r = ar, a32i = ai;
#pragma unroll
        for (int q = 0; q < 5; ++q) { const float nr = a32r * a32r - a32i * a32i, ni = 2.f * a32r * a32i; a32r = nr; a32i = ni; }
        float cr = 0.f, ci_ = 0.f;
#pragma unroll
        for (int s = 0; s < 3; ++s) if (s < seg) { const float er = E[(s * 128 + cl) * 2], ei = E[(s * 128 + cl) * 2 + 1]; const float nr = a32r * cr - a32i * ci_ + er, ni = a32r * ci_ + a32i * cr + ei; cr = nr; ci_ = ni; }
        float wr_ = 1.f, wi_ = 0.f;
#pragma unroll
        for (int jj = 0; jj < 32; ++jj) {
            const int j = seg * 32 + jj, ci = dir ? 127 - j : j;
            const float outr = pr[jj] + wr_ * cr - wi_ * ci_, outi = pi[jj] + wr_ * ci_ + wi_ * cr;
            bf16_t* d = ucat + (size_t)(rowbase + ci) * UCK + 512 + comp;
            d[0] = (bf16_t)(pk_bf16(outr, 0.f) & 0xffffu); d[64] = (bf16_t)(pk_bf16(outi, 0.f) & 0xffffu);
            const float nr = wr_ * ar - wi_ * ai, ni = wr_ * ai + wi_ * ar; wr_ = nr; wi_ = ni;
        }
    }
    __syncthreads();
}

#define XB_TMO      128
#define XB_XCNT(j)  (256  + 64 * (j))
#define XB_XSUB(j)  (1280 + 64 * (j))
#define XB_XGEN(j)  (2304 + 64 * (j))
#define XB_TOP      3328
#define XB_TOPGEN   3392
#define XCD_BAR_WORDS 3456
#define XB_SPIN_CAP (1u << 18)
DI unsigned xb_ld(unsigned* p)              { return __hip_atomic_load(p, __ATOMIC_RELAXED, __HIP_MEMORY_SCOPE_AGENT); }
DI unsigned xb_add(unsigned* p, unsigned v) { return __hip_atomic_fetch_add(p, v, __ATOMIC_RELAXED, __HIP_MEMORY_SCOPE_AGENT); }
DI unsigned xb_xcc_id() { return (unsigned)__builtin_amdgcn_s_getreg((3 << 11) | 20) & 0xFu; }
#define XB_SPIN(cond, bar) do { unsigned _sp = 0; while (cond) { __builtin_amdgcn_s_sleep(1); \
    if ((++_sp & 255u) == 0u) { if (xb_ld(&(bar)[XB_TMO])) break; if (_sp > XB_SPIN_CAP) { atomicAdd(&(bar)[XB_TMO], 1u); break; } } } } while (0)
struct XcdBarrier { unsigned* bar; unsigned x; volatile LAS unsigned* st; };
DI XcdBarrier xcd_barrier_post(unsigned* bar, volatile LAS unsigned* st) {
    XcdBarrier b; b.bar = bar; b.x = xb_xcc_id(); b.st = st;
    if (threadIdx.x == 0) (void)xb_add(&bar[XB_XCNT(b.x)], 1u);
    return b;
}
DI void xcd_barrier_complete(unsigned* bar, unsigned x, unsigned& nloc, unsigned& nx) {
    const unsigned G = gridDim.x * gridDim.y * gridDim.z;
    unsigned sum, cnt, mine, sp = 0u;
    for (;;) {
        sum = 0u; cnt = 0u; mine = 0u;
#pragma unroll
        for (unsigned j = 0; j < 16; ++j) { const unsigned c = xb_ld(&bar[XB_XCNT(j)]); sum += c; cnt += (c > 0u) ? 1u : 0u; mine = (j == x) ? c : mine; }
        if (sum == G) break;
        __builtin_amdgcn_s_sleep(1);
        if ((++sp & 255u) == 0u) { if (xb_ld(&bar[XB_TMO])) break; if (sp > XB_SPIN_CAP) { atomicAdd(&bar[XB_TMO], 1u); break; } }
    }
    nloc = mine > 0u ? mine : 1u; nx = cnt > 0u ? cnt : 1u;
}
DI void xcd_barrier(const XcdBarrier& b) {
    asm volatile("s_waitcnt vmcnt(0)" ::: "memory");
    __syncthreads();
    if (threadIdx.x == 0) {
        unsigned* bar = b.bar;
        __builtin_amdgcn_s_waitcnt(0);
        unsigned nloc = b.st[0], nx = b.st[1];
        if (nloc == 0u) { xcd_barrier_complete(bar, b.x, nloc, nx); b.st[0] = nloc; b.st[1] = nx; }
        const unsigned old = xb_add(&bar[XB_XSUB(b.x)], 1u);
        const unsigned gen = old / nloc;
        if (old + 1u == (gen + 1u) * nloc) {
            __builtin_amdgcn_fence(__ATOMIC_RELEASE, "agent");
            asm volatile("s_waitcnt vmcnt(0)" ::: "memory");
            const unsigned og = xb_add(&bar[XB_TOP], 1u);
            const unsigned tg = og / nx;
            if (og + 1u == (tg + 1u) * nx) xb_add(&bar[XB_TOPGEN], 1u);
            else XB_SPIN(xb_ld(&bar[XB_TOPGEN]) == tg, bar);
            __builtin_amdgcn_fence(__ATOMIC_ACQUIRE, "agent");
            xb_add(&bar[XB_XGEN(b.x)], 1u);
            asm volatile("s_waitcnt vmcnt(0)" ::: "memory");
        } else {
            XB_SPIN(xb_ld(&bar[XB_XGEN(b.x)]) == gen, bar);
            __builtin_amdgcn_fence(__ATOMIC_ACQUIRE, "agent");
            asm volatile("s_waitcnt vmcnt(0)" ::: "memory");
        }
    }
    __syncthreads();
}

struct Args { const float* in[21]; float* out; unsigned char* ws; int ph_lo, ph_hi, li, pad; };
constexpr int NPHASE = 11;

__global__ void __launch_bounds__(512, 2) mk_fwd(Args args) {
    extern __shared__ __attribute__((aligned(16))) unsigned char lds_raw[];
    LAS unsigned char* lds = (LAS unsigned char*)lds_raw;
    const int tid = threadIdx.x, lane = tid & 63, wid = __builtin_amdgcn_readfirstlane(tid >> 6);
    const int G = gridDim.x, bx = blockIdx.x;
    const int gw = bx * 8 + wid, NGW = G * 8;
    unsigned char* ws = args.ws;
    const float* x = args.in[0];
    bf16_t* WinT = (bf16_t*)(ws + WS_WINT); bf16_t* SWin = (bf16_t*)(ws + WS_SWIN); bf16_t* Bt2 = (bf16_t*)(ws + WS_BT2); bf16_t* WgluT = (bf16_t*)(ws + WS_WGLUT);
    bf16_t* BtCat = (bf16_t*)(ws + WS_BTCAT); bf16_t* WoT = (bf16_t*)(ws + WS_WOT); bf16_t* BtFfn = (bf16_t*)(ws + WS_BTFFN); bf16_t* WdT = (bf16_t*)(ws + WS_WDT);
    float* rope = (float*)(ws + WS_ROPE); float* lamT = (float*)(ws + WS_LAMT); float* ssq1 = (float*)(ws + WS_SSQ1); float* ssq2 = (float*)(ws + WS_SSQ2);
    bf16_t* H1 = (bf16_t*)(ws + WS_H1); bf16_t* AS = (bf16_t*)(ws + WS_AS); bf16_t* Qb = (bf16_t*)(ws + WS_Q); bf16_t* yg = (bf16_t*)(ws + WS_YG);
    bf16_t* Kb = (bf16_t*)(ws + WS_K); bf16_t* Vb = (bf16_t*)(ws + WS_V); bf16_t* ucat = (bf16_t*)(ws + WS_UCAT); bf16_t* Mg = (bf16_t*)(ws + WS_MG);
    float* Fst = (float*)(ws + WS_F); bf16_t* Ga = (bf16_t*)(ws + WS_GA); bf16_t* Gs = (bf16_t*)(ws + WS_GS); bf16_t* Xb = (bf16_t*)(ws + WS_XB); bf16_t* Hmid = (bf16_t*)(ws + WS_HMID);
    float* out = args.out; bf16_t* X2b = (bf16_t*)(ws + WS_GA);
    const int lo = args.ph_lo, hi = args.ph_hi;
    if (lo < 0) cg::this_grid().sync();
    volatile LAS unsigned* xst = (volatile LAS unsigned*)(lds + 131072);
    if (tid == 0) { xst[0] = 0u; xst[1] = 0u; xst[2] = 0u; xst[3] = 0u; }
    __syncthreads();
    const XcdBarrier xbar = xcd_barrier_post((unsigned*)(ws + WS_BAR) + args.li * XCD_BAR_WORDS, xst);
#ifndef PHASE_MASK
#define PHASE_MASK 0x7ff
#endif
#define IN(k) (((PHASE_MASK >> (k)) & 1) && lo <= (k) && (k) < hi)
#if MK_PER_PHASE
#define SEAM(k) do { } while (0)
#else
#define SEAM(k) do { if (IN(k) && IN((k) + 1)) xcd_barrier(xbar); } while (0)
#endif

#define DEFERRED_TRANSPOSES(it0, it1) do { if (bx >= 128) { LAS float* scr = (LAS float*)(lds + wid * 8448); \
        constexpr int I_GLU = 8 * 16, I_AB = 8 * 32, I_SB = 8 * 32, I_O = 16 * 32, I_G = 16 * 88, I_U = 16 * 88; \
        for (int it = (it0) + (bx - 128) * 8 + wid; it < (it1); it += (G - 128) * 8) { int r = it; \
            if (r < I_GLU) { tr_item(args.in[12], 512, 512, WgluT, 512, 0, 0, nullptr, scr, r, lane); continue; } r -= I_GLU; \
            if (r < I_AB) { tr_item(args.in[13], 512, DM, BtCat, DM, 0, 0, nullptr, scr, r, lane); continue; } r -= I_AB; \
            if (r < I_SB) { tr_item(args.in[14], 512, DM, BtCat, DM, 512, 0, nullptr, scr, r, lane); continue; } r -= I_SB; \
            if (r < I_O) { tr_item(args.in[15], DM, DM, WoT, DM, 0, 0, nullptr, scr, r, lane); continue; } r -= I_O; \
            if (r < I_G) { tr_item(args.in[17], DM, DFF, BtFfn, DM, 0, 1, args.in[16], scr, r, lane); continue; } r -= I_G; \
            if (r < I_U) { tr_item(args.in[18], DM, DFF, BtFfn, DM, 0, 2, args.in[16], scr, r, lane); continue; } r -= I_U; \
            tr_item(args.in[19], DFF, DM, WdT, DFF, 0, 0, nullptr, scr, r, lane); } \
        __syncthreads(); } } while (0)
    constexpr int N_DEFERRED = 8 * 16 + 8 * 32 + 8 * 32 + 16 * 32 + 16 * 88 + 16 * 88 + 44 * 32, N_DEF_P1 = N_DEFERRED;

    if (IN(0)) {
        if (bx < 64) ssm_tables(lds, bx >> 1, bx & 1, args.in[4], args.in[5], args.in[6], args.in[7], args.in[8], args.in[9], args.in[10], args.in[11], SWin, Bt2, lamT);
        else if (bx < 128) {
            const int i = (bx - 64) * 512 + tid;
            const int pos = i >> 3, j = i & 7; const float inv = powf(500000.0f, -(float)j / 8.0f); float sn, cs; sincosf((float)pos * inv, &sn, &cs);
            rope[pos * 16 + j] = cs; rope[pos * 16 + 8 + j] = sn;
        }
        {
            LAS float* scr = (LAS float*)(lds + wid * 8448);
            constexpr int NTR = 16 * 104, NITEMS = NTR + NTOK / 4;
            const float* g1 = args.in[1];
            f32x4 g1v[4];
#pragma unroll
            for (int j = 0; j < 4; ++j) g1v[j] = *((const f32x4*)g1 + lane + 64 * j);
            const int nslot = (G - 64) * 16 + 256;
            const int s0_ = bx >= 64 ? ((bx - 64) * 8 + wid) * 2 : (G - 64) * 16 + bx * 4 + (wid & 3), ns_ = bx >= 64 ? 2 : (wid < 4 ? 1 : 0);
            for (int itb = 0; itb < NITEMS; itb += nslot)
            for (int sub = 0; sub < ns_; ++sub) {
                const int it = itb + s0_ + sub; if (it >= NITEMS) break;
                int r = it;
                if (r >= NTR) {
                    const int m0 = (r - NTR) * 4;
                    f32x4 v[4][4]; float ssv[4];
#pragma unroll
                    for (int q = 0; q < 4; ++q) { const f32x4* xr = (const f32x4*)(x + (size_t)(m0 + q) * DM) + lane;
#pragma unroll
                        for (int j = 0; j < 4; ++j) v[q][j] = __builtin_nontemporal_load(xr + 64 * j); }
#pragma unroll
                    for (int q = 0; q < 4; ++q) { float s_ = 0.f;
#pragma unroll
                        for (int j = 0; j < 4; ++j) s_ += (v[q][j][0] * v[q][j][0] + v[q][j][1] * v[q][j][1]) + (v[q][j][2] * v[q][j][2] + v[q][j][3] * v[q][j][3]);
                        ssv[q] = 1.0f / sqrtf(wave_sum(s_) * (1.0f / DM) + RMS_EPS); }
#pragma unroll
                    for (int j = 0; j < 4; ++j) { const f32x4 gv = g1v[j];
#pragma unroll
                        for (int q = 0; q < 4; ++q) { const f32x4 w = v[q][j] * ssv[q] * gv; u32x2 o; o.x = pk_bf16(w[0], w[1]); o.y = pk_bf16(w[2], w[3]); *((u32x2*)(H1 + (size_t)(m0 + q) * DM) + lane + 64 * j) = o; } }
                    continue;
                }
                tr_item(args.in[2], DM, INC, WinT, DM, 0, 3, nullptr, scr, r, lane);
            }
        }
        __syncthreads();
    }
    SEAM(0);
    if (IN(1)) {
        pg8::Gemm g{H1, WinT, DM, DM, DM, 16, 0, 0}; pg8::StaticOrder S; S.init(NTOK / 256, INC / 256, G, bx);
        EpiIn E{Qb, Kb, Vb, ucat, Ga, Gs, rope};
        pg8::gemm_phase(lds, g, S, E);
        DEFERRED_TRANSPOSES(0, N_DEF_P1);
    }
    SEAM(1);
    if (IN(2)) {
        {
            pg8::Gemm g{ucat, SWin, UCK, 512, 512, 16, 0, 0}; pg8::GroupOrder S; S.init(32, 4, 1, G, bx); EpiF E{Fst}; pg8::gemm_phase(lds, g, S, E);
            for (int i = 0; ; ++i) { Unit u; if (!S.next(i, u)) break;
                asm volatile("s_waitcnt vmcnt(0)" ::: "memory"); __syncthreads();
                scan_blk(lds, Fst, lamT, ucat, u.pm * 2); scan_blk(lds, Fst, lamT, ucat, u.pm * 2 + 1); }
        }
        DEFERRED_TRANSPOSES(N_DEF_P1, N_DEFERRED);
        {
            int u0, u1;
            if (G == 256) { if (bx < 128) { u0 = bx * 3; u1 = u0 + 3; } else { u0 = 384 + (bx - 128) * 5; u1 = u0 + 5; } }
            else { const int per = (1024 + G - 1) / G; u0 = bx * per; u1 = u0 + per < 1024 ? u0 + per : 1024; if (u0 > 1024) u0 = 1024; }
            attn_phase(lds, Qb, Kb, Vb, AS, args.in[3], u0, u1);
        }
    }
    SEAM(2);
    if (IN(4)) { pg8::Gemm g{ucat, Bt2, UCK, UCK, UCK, 16, 0, 0}; pg8::GroupOrder S; S.init(32, 4, 2, G, bx); EpiY E{yg}; pg8::gemm_phase(lds, g, S, E); }
    SEAM(4);
    if (IN(5)) { pg8::Gemm g{yg, WgluT, 16, 512, 512, NTOK * 16, 0, 0}; pg8::StaticOrder S; S.init(NTOK / 256, 2, G, bx); EpiGlu E{yg, AS}; pg8::gemm_phase(lds, g, S, E); }
    SEAM(5);
    if (IN(6)) { pg8::Gemm g{AS, BtCat, DM, DM, 512, 16, 1024, 1024}; pg8::StaticOrder S; S.init(NTOK / 256, 4, G, bx, 1); EpiMerge E{Ga, Gs, Mg}; pg8::gemm_phase(lds, g, S, E); }
    SEAM(6);
    if (IN(7)) { pg8::Gemm g{Mg, WoT, DM, DM, DM, 16, 0, 0}; pg8::StaticOrder S; S.init(NTOK / 256, 4, G, bx); EpiRes<false> E{x, nullptr, Xb, ssq1}; pg8::gemm_phase(lds, g, S, E); }
    SEAM(7);
    if (IN(8)) { pg8::Gemm g{Xb, BtFfn, DM, DM, DM, 16, 0, 0}; pg8::StaticOrder S; S.init(NTOK / 256, 2 * DFF / 256, G, bx); EpiFfn1 E{ssq1, Hmid}; pg8::gemm_phase(lds, g, S, E); }
    SEAM(8);
    if (IN(9)) { pg8::Gemm g{Hmid, WdT, DFF, DFF, DFF, 16, 0, 0}; pg8::StaticOrder S; S.init(NTOK / 256, 4, G, bx); EpiRes<true> E{nullptr, Xb, X2b, ssq2}; pg8::gemm_phase(lds, g, S, E); }
    SEAM(9);
#ifdef MK_EXTRA_SYNCS
    if (IN(9)) for (int e = 0; e < MK_EXTRA_SYNCS; ++e) xcd_barrier(xbar);
#endif
    if (IN(10)) {
        const float* gf = args.in[20];
        f32x4 gv[4];
#pragma unroll
        for (int j = 0; j < 4; ++j) gv[j] = *((const f32x4*)gf + lane + 64 * j);
        for (int m0 = gw * 4; m0 < NTOK; m0 += NGW * 4) {
            u32x2 w[4][4]; float rsv[4];
#pragma unroll
            for (int q = 0; q < 4; ++q) {
                const u32x2* xr = (const u32x2*)(X2b + (size_t)(m0 + q) * DM) + lane;
#pragma unroll
                for (int j = 0; j < 4; ++j) w[q][j] = __builtin_nontemporal_load(xr + 64 * j);
                rsv[q] = ssq2[(size_t)(m0 + q) * 16 + (lane & 15)];
            }
#pragma unroll
            for (int q = 0; q < 4; ++q) {
                float tot = rsv[q]; tot += __shfl_xor(tot, 1); tot += __shfl_xor(tot, 2); tot += __shfl_xor(tot, 4); tot += __shfl_xor(tot, 8);
                const float rs = 1.0f / sqrtf(tot * (1.0f / DM) + RMS_EPS);
                f32x4* orow = (f32x4*)(out + (size_t)(m0 + q) * DM) + lane;
#pragma unroll
                for (int j = 0; j < 4; ++j) { f32x4 v; v[0] = bf_lo(w[q][j].x); v[1] = bf_hi(w[q][j].x); v[2] = bf_lo(w[q][j].y); v[3] = bf_hi(w[q][j].y); __builtin_nontemporal_store(v * rs * gv[j], orow + 64 * j); }
            }
        }
    }
}

extern "C" void kernel_launch(void* const* d_in, const int* in_sizes, int n_in, void* d_out, int out_size, void* d_ws, size_t ws_size, hipStream_t stream) {
    static int grid = 0;
    if (grid == 0) {
        if (n_in != 21 || in_sizes[0] != NTOK * DM || out_size != NTOK * DM || ws_size < WS_END) {
            fprintf(stderr, "kernel_launch: unexpected shapes (n_in %d, in0 %d, out %d, ws %zu); nothing launched\n", n_in, n_in > 0 ? in_sizes[0] : -1, out_size, ws_size); grid = -1; return; }
        int dev = 0, cus = 0, per_cu = 0;
        hipGetDevice(&dev); hipDeviceGetAttribute(&cus, hipDeviceAttributeMultiprocessorCount, dev);
        if (hipFuncSetAttribute((const void*)mk_fwd, hipFuncAttributeMaxDynamicSharedMemorySize, LDS_BYTES) != hipSuccess) { fprintf(stderr, "kernel_launch: hipFuncSetAttribute failed\n"); grid = -1; return; }
        if (hipOccupancyMaxActiveBlocksPerMultiprocessor(&per_cu, (const void*)mk_fwd, 512, LDS_BYTES) != hipSuccess || per_cu < 1) { fprintf(stderr, "kernel_launch: occupancy query says %d\n", per_cu); per_cu = 1; }
        (void)hipGetLastError();
        grid = cus * 1;
    }
    if (grid < 0) return;
    Args a{};
    for (int i = 0; i < 21; ++i) a.in[i] = (const float*)d_in[i];
    a.out = (float*)d_out; a.ws = (unsigned char*)d_ws;
    static const int ranges[][2] = {MK_RANGES};
    static_assert(sizeof(ranges) / sizeof(ranges[0]) <= 4, "one barrier-word region per launch");
    if (hipMemsetAsync((char*)d_ws + WS_BAR, 0, 4 * XCD_BAR_WORDS * 4 + 1024, stream) != hipSuccess) { fprintf(stderr, "kernel_launch: hipMemsetAsync failed\n"); return; }
    for (unsigned li = 0; li < sizeof(ranges) / sizeof(ranges[0]); ++li) {
        a.ph_lo = ranges[li][0]; a.ph_hi = ranges[li][1]; a.li = (int)li;
        void* kargs[] = {&a};
        hipError_t e = hipLaunchCooperativeKernel((const void*)mk_fwd, dim3(grid), dim3(512), kargs, LDS_BYTES, stream);
        if (e != hipSuccess) fprintf(stderr, "kernel_launch: cooperative launch failed: %s (grid %d)\n", hipGetErrorString(e), grid);
    }
}
```
